# Optimizing an MI355X kernel written in HIP

```python
import jax, jax.numpy as jnp
from jax import lax
import numpy as np

D_MODEL = 4096
BATCH = 4
SEQ = 4096
DEPTH = 2

N_MIXERS = 2
N_ATTN_LAYERS = (DEPTH + 1) // 2
N_CONV_LAYERS = DEPTH // 2
HEAD_DIM = 128
N_Q_HEADS = D_MODEL // HEAD_DIM
N_KV_HEADS = N_Q_HEADS // 4
GQA_GROUP = N_Q_HEADS // N_KV_HEADS
QKV_DIM = (N_Q_HEADS + 2 * N_KV_HEADS) * HEAD_DIM
Q_BLOCK = 128
ROPE_THETA = 10000.0
GRID_W = 64
AXIS_DIM = HEAD_DIM // 2
AXIS_FREQS = AXIS_DIM // 2
CONV_WIDTH = 3
CONV_DIM = D_MODEL
PEER_HEADS = 8
N_KEYS = 128
N_EXPERTS = N_KEYS * N_KEYS
PEER_QUERY_DIM = 256
PEER_HALF = PEER_QUERY_DIM // 2
PEER_TOPK = 16
PEER_SLOTS = PEER_HEADS * PEER_TOPK
PEER_TOKEN_BLOCK = 128
EPS = 1e-6

kernel_name = "hybrid_gqa_shortconv_peer_encoder"


def rms_norm(x, g):
    xf = x.astype(jnp.float32)
    y = xf * lax.rsqrt(jnp.mean(xf * xf, axis=-1, keepdims=True) + EPS)
    return (y * g.astype(jnp.float32)).astype(x.dtype)


def axial_rope_tables(seq_len):
    rows = seq_len // GRID_W
    row_idx = jnp.broadcast_to(jnp.arange(rows, dtype=jnp.float32)[:, None], (rows, GRID_W)).reshape(seq_len)
    col_idx = jnp.broadcast_to(jnp.arange(GRID_W, dtype=jnp.float32)[None, :], (rows, GRID_W)).reshape(seq_len)
    inv_freq = ROPE_THETA ** (-jnp.arange(0, AXIS_DIM, 2, dtype=jnp.float32) / AXIS_DIM)
    ang = jnp.stack([row_idx[:, None] * inv_freq, col_idx[:, None] * inv_freq], axis=1)
    return jnp.cos(ang), jnp.sin(ang)


def apply_axial_rope(x, cos, sin):
    lead = x.shape[:-1]
    xr = x.reshape(lead + (2, 2, AXIS_FREQS))
    x1, x2 = xr[..., 0, :], xr[..., 1, :]
    bshape = (cos.shape[0],) + (1,) * (x.ndim - 3) + (2, AXIS_FREQS)
    c = cos.reshape(bshape).astype(x.dtype)
    s = sin.reshape(bshape).astype(x.dtype)
    out = jnp.stack([x1 * c - x2 * s, x2 * c + x1 * s], axis=-2)
    return out.reshape(x.shape)


def attention_mixer(h, w_qkv, w_o, q_gain, k_gain):
    B, S, _ = h.shape
    qkv = h @ w_qkv
    q, k, v = jnp.split(qkv, [N_Q_HEADS * HEAD_DIM, (N_Q_HEADS + N_KV_HEADS) * HEAD_DIM], axis=-1)
    q = q.reshape(B, S, N_KV_HEADS, GQA_GROUP, HEAD_DIM)
    k = k.reshape(B, S, N_KV_HEADS, HEAD_DIM)
    v = v.reshape(B, S, N_KV_HEADS, HEAD_DIM)
    q = rms_norm(q, q_gain)
    k = rms_norm(k, k_gain)
    cos, sin = axial_rope_tables(S)
    q = apply_axial_rope(q, cos, sin)
    k = apply_axial_rope(k, cos, sin)
    scale = HEAD_DIM ** -0.5
    n_blk = S // Q_BLOCK
    qb = jnp.moveaxis(q.reshape(B, n_blk, Q_BLOCK, N_KV_HEADS, GQA_GROUP, HEAD_DIM), 1, 0)

    def one_block(qblk):
        s = jnp.einsum('bqkgd,bskd->bkgqs', qblk, k).astype(jnp.float32) * scale
        p = jax.nn.softmax(s, axis=-1).astype(v.dtype)
        return jnp.einsum('bkgqs,bskd->bqkgd', p, v)

    o = lax.map(one_block, qb)
    o = jnp.moveaxis(o, 0, 1).reshape(B, S, N_Q_HEADS * HEAD_DIM)
    return o @ w_o


def short_conv_mixer(h, w_in, conv_w, conv_b, w_out):
    S = h.shape[1]
    bcx = h @ w_in
    b_gate, c_gate, xin = jnp.split(bcx, 3, axis=-1)
    u = c_gate * xin
    up = jnp.pad(u, ((0, 0), (1, 1), (0, 0)))
    conv = (up[:, 0:S] * conv_w[0] + up[:, 1:S + 1] * conv_w[1]
            + up[:, 2:S + 2] * conv_w[2] + conv_b)
    return (b_gate * conv) @ w_out


def peer_ffn(h, w_query, sub_keys, expert_u, expert_v):
    B, S, D = h.shape
    T = B * S
    xt = h.reshape(T, D)
    q = (xt @ w_query).reshape(T, PEER_HEADS, 2, PEER_HALF)
    scores = jnp.einsum('thpd,hpnd->thpn', q, sub_keys).astype(jnp.float32)
    top_s, top_i = lax.top_k(scores, PEER_TOPK)
    cand_s = top_s[:, :, 0, :, None] + top_s[:, :, 1, None, :]
    cand_i = top_i[:, :, 0, :, None] * N_KEYS + top_i[:, :, 1, None, :]
    cand_s = cand_s.reshape(T, PEER_HEADS, PEER_TOPK * PEER_TOPK)
    cand_i = cand_i.reshape(T, PEER_HEADS, PEER_TOPK * PEER_TOPK)
    best_s, pos = lax.top_k(cand_s, PEER_TOPK)
    expert_idx = jnp.take_along_axis(cand_i, pos, axis=-1).reshape(T, PEER_SLOTS)
    gates = jax.nn.softmax(best_s, axis=-1).astype(h.dtype).reshape(T, PEER_SLOTS)
    n_blk = T // PEER_TOKEN_BLOCK

    def one_block(args):
        xb, idx, g = args
        u = expert_u[idx]
        act = jax.nn.gelu(jnp.einsum('td,tkd->tk', xb, u), approximate=False)
        v = expert_v[idx]
        return jnp.einsum('tk,tkd->td', g * act, v)

    out = lax.map(one_block, (xt.reshape(n_blk, PEER_TOKEN_BLOCK, D),
                              expert_idx.reshape(n_blk, PEER_TOKEN_BLOCK, PEER_SLOTS),
                              gates.reshape(n_blk, PEER_TOKEN_BLOCK, PEER_SLOTS)))
    return out.reshape(B, S, D)


def setup_inputs(seed: int = 0) -> dict:
    key = jax.random.key(seed)
    ks = jax.random.split(key, 16)
    f32 = jnp.float32
    D = D_MODEL
    nrm = lambda k, shape, s: jax.random.normal(k, shape, f32) * s
    return {
        "x": nrm(ks[0], (BATCH, SEQ, D), 1.0),
        "mixer_norm_g": 1.0 + nrm(ks[1], (DEPTH, D), 0.01),
        "ffn_norm_g": 1.0 + nrm(ks[2], (DEPTH, D), 0.01),
        "attn_w_qkv": nrm(ks[3], (N_ATTN_LAYERS, D, QKV_DIM), D ** -0.5),
        "attn_w_o": nrm(ks[4], (N_ATTN_LAYERS, N_Q_HEADS * HEAD_DIM, D), (N_Q_HEADS * HEAD_DIM) ** -0.5),
        "attn_q_gain": 1.0 + nrm(ks[5], (N_ATTN_LAYERS, HEAD_DIM), 0.01),
        "attn_k_gain": 1.0 + nrm(ks[6], (N_ATTN_LAYERS, HEAD_DIM), 0.01),
        "conv_w_in": nrm(ks[7], (N_CONV_LAYERS, D, 3 * CONV_DIM), D ** -0.5),
        "conv_w": nrm(ks[8], (N_CONV_LAYERS, CONV_WIDTH, CONV_DIM), CONV_WIDTH ** -0.5),
        "conv_b": nrm(ks[9], (N_CONV_LAYERS, CONV_DIM), 0.01),
        "conv_w_out": nrm(ks[10], (N_CONV_LAYERS, CONV_DIM, D), CONV_DIM ** -0.5),
        "peer_w_query": nrm(ks[11], (DEPTH, D, PEER_HEADS * PEER_QUERY_DIM), D ** -0.5),
        "peer_sub_keys": nrm(ks[12], (DEPTH, PEER_HEADS, 2, N_KEYS, PEER_HALF), PEER_HALF ** -0.5),
        "peer_u": nrm(ks[13], (DEPTH, N_EXPERTS, D), D ** -0.5),
        "peer_v": nrm(ks[14], (DEPTH, N_EXPERTS, D), PEER_SLOTS ** -0.5),
    }


def reference(x, mixer_norm_g, ffn_norm_g, attn_w_qkv, attn_w_o, attn_q_gain, attn_k_gain,
              conv_w_in, conv_w, conv_b, conv_w_out, peer_w_query, peer_sub_keys, peer_u, peer_v):
    h = x
    for layer in range(DEPTH):
        hn = rms_norm(h, mixer_norm_g[layer])
        j = layer // N_MIXERS
        if layer % N_MIXERS == 0:
            mix = attention_mixer(hn, attn_w_qkv[j], attn_w_o[j], attn_q_gain[j], attn_k_gain[j])
        else:
            mix = short_conv_mixer(hn, conv_w_in[j], conv_w[j], conv_b[j], conv_w_out[j])
        h = h + mix
        h = h + peer_ffn(rms_norm(h, ffn_norm_g[layer]), peer_w_query[layer], peer_sub_keys[layer],
                         peer_u[layer], peer_v[layer])
    return h
```

```cpp
#include <hip/hip_runtime.h>
#include <cstdio>
#include <cstdint>
namespace pg8 {
#define PG8_LAS __attribute__((address_space(3)))
typedef unsigned short bf16_t;
typedef short bf16x8 __attribute__((ext_vector_type(8)));
typedef float f32x4 __attribute__((ext_vector_type(4)));
typedef unsigned u32x4 __attribute__((ext_vector_type(4)));
typedef int v4i_t __attribute__((ext_vector_type(4)));
typedef int v8i_t __attribute__((ext_vector_type(8)));
constexpr int BM = 256, BK = 64, HALF = 128, HTB = HALF * BK * 2  , STAGE_BYTES = 8 * HTB, NXCD = 8, WGM = 8;

__host__ __device__ __forceinline__ int lds_byte(int r, int c) { const int st = (r >> 4) * 2 + (c >> 5), rr = r & 15, cc = c & 31, ob = rr * 64 + cc * 2; return st * 1024 + (ob ^ (((ob >> 9) & 1) << 5)); }
__host__ __device__ __forceinline__ void stage_rc(int b, int& R, int& C) { const int st = b / 1024, sb = b % 1024, swz = sb ^ (((sb >> 9) & 1) << 5); R = (st >> 1) * 16 + swz / 64; C = (st & 1) * 32 + (swz % 64) / 2; }
__host__ __device__ __forceinline__ int perm32(int rho) { const int n = rho >> 4, i = rho & 15; return 8 * (i >> 2) + 4 * n + (i & 3); }

struct Unit { int pm, pn; };
struct Gemm { const bf16_t* A; const bf16_t* Bt; int M, N, K; };

struct StaticOrder {
    int nM, nN, nwg, G, c;
    __host__ __device__ void init(int M, int N, int G_, int c_) { nM = M / BM; nN = N / BM; nwg = nM * nN; G = G_; c = c_; }
    __host__ __device__ bool next(int i, Unit& u) const {
        const long L = (long)i * G + c; if (L >= nwg) return false;
        int wgid = (int)L; { const int q = nwg / NXCD, r = nwg % NXCD, xcd = wgid % NXCD, off = wgid / NXCD; wgid = (xcd < r ? xcd * (q + 1) : r * (q + 1) + (xcd - r) * q) + off; }
        const int nig = WGM * nN, gid = wgid / nig, fm = gid * WGM, gsz = (nM - fm) < WGM ? (nM - fm) : WGM;
        u.pm = fm + ((wgid % nig) % gsz); u.pn = (wgid % nig) / gsz; return true;
    }
    __device__ __forceinline__ void a_ready(const Unit&) const {}
    __device__ __forceinline__ void done(const Unit&) const {}
};
__device__ __forceinline__ unsigned cvt_pk_bf16(float lo, float hi) { unsigned r; asm volatile("v_cvt_pk_bf16_f32 %0, %1, %2" : "=v"(r) : "v"(lo), "v"(hi)); return r; }
typedef float f32x2 __attribute__((ext_vector_type(2)));
__device__ __forceinline__ f32x2 gelu_pk(f32x2 v) {
    const f32x2 av = __builtin_elementwise_abs(v), d = av * 0.2316418882f + 1.0f;
    f32x2 t; t.x = __builtin_amdgcn_rcpf(d.x); t.y = __builtin_amdgcn_rcpf(d.y);
    f32x2 q = t * 0.5307027145f + (-0.7265760135f); q = q * t + 0.7107068705f; q = q * t + (-0.142248368f); q = q * t + 0.127414796f; q = q * t;
    const f32x2 s = (v * v) * (-0.72134752044f);
    f32x2 e; e.x = __builtin_amdgcn_exp2f(s.x); e.y = __builtin_amdgcn_exp2f(s.y);
    const f32x2 m = v * (q * e), r = v - m;
    f32x2 o; o.x = v.x < 0.f ? m.x : r.x; o.y = v.y < 0.f ? m.y : r.y; return o;
}

template <int ACT  > struct EpiBf16 {
    static constexpr bool PERM = true, AFTER_DRAIN = false; static_assert(ACT == 0 || ACT == 1, "EpiBf16: ACT is 0 (none) or 1 (gelu_pk)");
    bf16_t* O; int ldc; const float* bias; int split_cols; size_t split_stride; float scale0;
    __device__ __forceinline__ void operator()(const f32x4 (&acc)[2][2][4][2], const Unit& u, int wr, int wc, int fr, int fq) const {
        const int row0 = u.pm * BM + wr * 64 + fr; int colt = u.pn * BM; bf16_t* base = O;
        float sc = 1.f; if (split_cols) { const int t = colt / split_cols; base += (size_t)t * split_stride; colt -= t * split_cols; if (t == 0) sc = scale0; }
        const int col0 = colt + wc * 32 + 8 * fq, bcol0 = u.pn * BM + wc * 32 + 8 * fq;
        f32x4 bv[2][2];
#pragma unroll
        for (int bj = 0; bj < 2; ++bj)
#pragma unroll
            for (int n = 0; n < 2; ++n) bv[bj][n] = bias ? *(const f32x4*)(bias + bcol0 + bj * HALF + 4 * n) : (f32x4){0.f, 0.f, 0.f, 0.f};
#pragma unroll
        for (int ai = 0; ai < 2; ++ai)
#pragma unroll
            for (int m = 0; m < 4; ++m) { bf16_t* rowp = base + (size_t)(row0 + ai * HALF + m * 16) * ldc + col0;
#pragma unroll
                for (int bj = 0; bj < 2; ++bj) { f32x4 v0 = acc[ai][bj][m][0] + bv[bj][0], v1 = acc[ai][bj][m][1] + bv[bj][1];
                    if (ACT == 1) { f32x2 a = gelu_pk((f32x2){v0[0], v0[1]}), b = gelu_pk((f32x2){v0[2], v0[3]}), c = gelu_pk((f32x2){v1[0], v1[1]}), d = gelu_pk((f32x2){v1[2], v1[3]});
                        v0 = (f32x4){a.x, a.y, b.x, b.y}; v1 = (f32x4){c.x, c.y, d.x, d.y}; }
                    v0 = v0 * sc; v1 = v1 * sc; u32x4 w; w.x = cvt_pk_bf16(v0[0], v0[1]); w.y = cvt_pk_bf16(v0[2], v0[3]); w.z = cvt_pk_bf16(v1[0], v1[1]); w.w = cvt_pk_bf16(v1[2], v1[3]);
                    *(u32x4*)(rowp + bj * HALF) = w; } }
    }
};
struct EpiF32Res {
    static constexpr bool PERM = false, AFTER_DRAIN = false;
    float* C; const float* R; int ldc;
    __device__ __forceinline__ void operator()(const f32x4 (&acc)[2][2][4][2], const Unit& u, int wr, int wc, int fr, int fq) const {
        const int row0 = u.pm * BM + wr * 64 + fr, col0 = u.pn * BM + wc * 32 + 4 * fq;
#pragma unroll
        for (int ai = 0; ai < 2; ++ai)
#pragma unroll
            for (int m = 0; m < 4; ++m) { const size_t off = (size_t)(row0 + ai * HALF + m * 16) * ldc + col0;
#pragma unroll
                for (int bj = 0; bj < 2; ++bj)
#pragma unroll
                    for (int n = 0; n < 2; ++n) { const f32x4 r = *(const f32x4*)(R + off + bj * HALF + n * 16); *(f32x4*)(C + off + bj * HALF + n * 16) = acc[ai][bj][m][n] + r; } }
    }
};
struct EpiConvIn {
    static constexpr bool PERM = true, AFTER_DRAIN = false;
    bf16_t* Bg; bf16_t* U; int ld; const float* rs;
    __device__ __forceinline__ void operator()(const f32x4 (&acc)[2][2][4][2], const Unit& u, int wr, int wc, int fr, int fq) const {
        const int row0 = u.pm * BM + wr * 64 + fr;
        if (u.pn < 16) {
            const int col0 = u.pn * BM + wc * 32 + 8 * fq;
#pragma unroll
            for (int ai = 0; ai < 2; ++ai)
#pragma unroll
                for (int m = 0; m < 4; ++m) { bf16_t* rowp = Bg + (size_t)(row0 + ai * HALF + m * 16) * ld + col0; const float r = rs[row0 + ai * HALF + m * 16];
#pragma unroll
                    for (int bj = 0; bj < 2; ++bj) { const f32x4 v0 = acc[ai][bj][m][0] * r, v1 = acc[ai][bj][m][1] * r;
                        u32x4 w; w.x = cvt_pk_bf16(v0[0], v0[1]); w.y = cvt_pk_bf16(v0[2], v0[3]); w.z = cvt_pk_bf16(v1[0], v1[1]); w.w = cvt_pk_bf16(v1[2], v1[3]);
                        *(u32x4*)(rowp + bj * HALF) = w; } }
        } else {
            const int col0 = (u.pn - 16) * HALF + wc * 32 + 8 * fq;
#pragma unroll
            for (int ai = 0; ai < 2; ++ai)
#pragma unroll
                for (int m = 0; m < 4; ++m) { const float r = rs[row0 + ai * HALF + m * 16], r2 = r * r; const f32x4 v0 = acc[ai][0][m][0] * acc[ai][1][m][0] * r2, v1 = acc[ai][0][m][1] * acc[ai][1][m][1] * r2;
                    u32x4 w; w.x = cvt_pk_bf16(v0[0], v0[1]); w.y = cvt_pk_bf16(v0[2], v0[3]); w.z = cvt_pk_bf16(v1[0], v1[1]); w.w = cvt_pk_bf16(v1[2], v1[3]);
                    *(u32x4*)(U + (size_t)(row0 + ai * HALF + m * 16) * ld + col0) = w; }
        }
    }
};
struct EpiBf16S {
    static constexpr bool PERM = true, AFTER_DRAIN = false;
    bf16_t* O; int ldc; const float* scp; float mul; unsigned* amax_word; int amax_col0;
    __device__ __forceinline__ void operator()(const f32x4 (&acc)[2][2][4][2], const Unit& u, int wr, int wc, int fr, int fq) const {
        const int row0 = u.pm * BM + wr * 64 + fr, col0 = u.pn * BM + wc * 32 + 8 * fq; const float sc = *scp * mul; float mx = 0.f;
#pragma unroll
        for (int ai = 0; ai < 2; ++ai)
#pragma unroll
            for (int m = 0; m < 4; ++m) { bf16_t* rowp = O + (size_t)(row0 + ai * HALF + m * 16) * ldc + col0;
#pragma unroll
                for (int bj = 0; bj < 2; ++bj) { const f32x4 v0 = acc[ai][bj][m][0] * sc, v1 = acc[ai][bj][m][1] * sc;
                    mx = fmaxf(mx, fmaxf(fmaxf(fmaxf(fabsf(v0[0]), fabsf(v0[1])), fmaxf(fabsf(v0[2]), fabsf(v0[3]))), fmaxf(fmaxf(fabsf(v1[0]), fabsf(v1[1])), fmaxf(fabsf(v1[2]), fabsf(v1[3])))));
                    u32x4 w; w.x = cvt_pk_bf16(v0[0], v0[1]); w.y = cvt_pk_bf16(v0[2], v0[3]); w.z = cvt_pk_bf16(v1[0], v1[1]); w.w = cvt_pk_bf16(v1[2], v1[3]);
                    *(u32x4*)(rowp + bj * HALF) = w; } }
        if (amax_word && u.pn * BM >= amax_col0) {
#pragma unroll
            for (int o = 1; o < 64; o <<= 1) mx = fmaxf(mx, __shfl_xor(mx, o));
            if ((threadIdx.x & 63) == 0) __hip_atomic_fetch_max(amax_word, __float_as_uint(mx), __ATOMIC_RELAXED, __HIP_MEMORY_SCOPE_AGENT); }
    }
};
struct EpiF32ResS {
    static constexpr bool PERM = false, AFTER_DRAIN = false;
    float* C; const float* R; int ldc; const float* s1; const float* s2;
    __device__ __forceinline__ void operator()(const f32x4 (&acc)[2][2][4][2], const Unit& u, int wr, int wc, int fr, int fq) const {
        const int row0 = u.pm * BM + wr * 64 + fr, col0 = u.pn * BM + wc * 32 + 4 * fq; const float sc = *s1 * *s2;
#pragma unroll
        for (int ai = 0; ai < 2; ++ai)
#pragma unroll
            for (int m = 0; m < 4; ++m) { const size_t off = (size_t)(row0 + ai * HALF + m * 16) * ldc + col0;
#pragma unroll
                for (int bj = 0; bj < 2; ++bj)
#pragma unroll
                    for (int n = 0; n < 2; ++n) { const f32x4 r = *(const f32x4*)(R + off + bj * HALF + n * 16); *(f32x4*)(C + off + bj * HALF + n * 16) = acc[ai][bj][m][n] * sc + r; } }
    }
};
struct EpiBf16ResS {
    static constexpr bool PERM = true, AFTER_DRAIN = false;
    bf16_t* O; const float* R; int ldc; const float* s1; const float* s2;
    __device__ __forceinline__ void operator()(const f32x4 (&acc)[2][2][4][2], const Unit& u, int wr, int wc, int fr, int fq) const {
        const int row0 = u.pm * BM + wr * 64 + fr, col0 = u.pn * BM + wc * 32 + 8 * fq; const float sc = *s1 * *s2;
#pragma unroll
        for (int ai = 0; ai < 2; ++ai)
#pragma unroll
            for (int m = 0; m < 4; ++m) { const size_t off = (size_t)(row0 + ai * HALF + m * 16) * ldc + col0;
#pragma unroll
                for (int bj = 0; bj < 2; ++bj) { const f32x4 r0 = *(const f32x4*)(R + off + bj * HALF), r1 = *(const f32x4*)(R + off + bj * HALF + 4);
                    const f32x4 v0 = acc[ai][bj][m][0] * sc + r0, v1 = acc[ai][bj][m][1] * sc + r1;
                    u32x4 w; w.x = cvt_pk_bf16(v0[0], v0[1]); w.y = cvt_pk_bf16(v0[2], v0[3]); w.z = cvt_pk_bf16(v1[0], v1[1]); w.w = cvt_pk_bf16(v1[2], v1[3]);
                    *(u32x4*)(O + off + bj * HALF) = w; } }
    }
};
struct EpiBf16Res {
    static constexpr bool PERM = true, AFTER_DRAIN = false;
    bf16_t* O; int ldc;
    __device__ __forceinline__ void operator()(const f32x4 (&acc)[2][2][4][2], const Unit& u, int wr, int wc, int fr, int fq) const {
        const int row0 = u.pm * BM + wr * 64 + fr, col0 = u.pn * BM + wc * 32 + 8 * fq;
#pragma unroll
        for (int ai = 0; ai < 2; ++ai)
#pragma unroll
            for (int m = 0; m < 4; ++m) { bf16_t* rowp = O + (size_t)(row0 + ai * HALF + m * 16) * ldc + col0;
#pragma unroll
                for (int bj = 0; bj < 2; ++bj) { const u32x4 r = *(const u32x4*)(rowp + bj * HALF); const f32x4 v0 = acc[ai][bj][m][0], v1 = acc[ai][bj][m][1];
                    u32x4 w; w.x = cvt_pk_bf16(v0[0] + __uint_as_float(r.x << 16), v0[1] + __uint_as_float(r.x & 0xffff0000u)); w.y = cvt_pk_bf16(v0[2] + __uint_as_float(r.y << 16), v0[3] + __uint_as_float(r.y & 0xffff0000u));
                    w.z = cvt_pk_bf16(v1[0] + __uint_as_float(r.z << 16), v1[1] + __uint_as_float(r.z & 0xffff0000u)); w.w = cvt_pk_bf16(v1[2] + __uint_as_float(r.w << 16), v1[3] + __uint_as_float(r.w & 0xffff0000u));
                    *(u32x4*)(rowp + bj * HALF) = w; } }
    }
};
struct EpiBf16Row {
    static constexpr bool PERM = true, AFTER_DRAIN = false;
    bf16_t* O; int ldc; const float* rs;
    __device__ __forceinline__ void operator()(const f32x4 (&acc)[2][2][4][2], const Unit& u, int wr, int wc, int fr, int fq) const {
        const int row0 = u.pm * BM + wr * 64 + fr, col0 = u.pn * BM + wc * 32 + 8 * fq;
#pragma unroll
        for (int ai = 0; ai < 2; ++ai)
#pragma unroll
            for (int m = 0; m < 4; ++m) { bf16_t* rowp = O + (size_t)(row0 + ai * HALF + m * 16) * ldc + col0; const float r = rs[row0 + ai * HALF + m * 16];
#pragma unroll
                for (int bj = 0; bj < 2; ++bj) { const f32x4 v0 = acc[ai][bj][m][0] * r, v1 = acc[ai][bj][m][1] * r;
                    u32x4 w; w.x = cvt_pk_bf16(v0[0], v0[1]); w.y = cvt_pk_bf16(v0[2], v0[3]); w.z = cvt_pk_bf16(v1[0], v1[1]); w.w = cvt_pk_bf16(v1[2], v1[3]);
                    *(u32x4*)(rowp + bj * HALF) = w; } }
    }
};
template <class Epi, class Sched, bool ALIGN_EPI = false, bool SP2 = false, bool F8 = false>
__device__ __forceinline__ void gemm_phase(PG8_LAS unsigned char* lds, const Gemm g, const Sched& S, const Epi& E) {
    const int tid = threadIdx.x, wid = __builtin_amdgcn_readfirstlane(tid >> 6), lane = tid & 63, wr = wid >> 2, wc = wid & 3, fr = lane & 15, fq = lane >> 4;
    const int K = g.K, nt = K / BK;
    unsigned voffA[2], voffB[2];
#pragma unroll
    for (int i = 0; i < 2; ++i) { int R, C; stage_rc(tid * 16 + i * 8192, R, C); const int Rb = Epi::PERM ? ((R & ~31) + perm32(R & 31)) : R;
        voffA[i] = (unsigned)(R * K + C) * 2u; voffB[i] = (unsigned)(Rb * K + C) * 2u; }
    const size_t kstep = (size_t)(BK * 2);
    const size_t hstep = (size_t)HALF * K * 2;
    const size_t tstep = 2 * hstep;
    const unsigned ldsw = (unsigned)wid * 1024u;
    const int aoff = lds_byte(wr * 64 + fr, fq * 8), boff = lds_byte(wc * 32 + fr, fq * 8);
#define PG8_SA(b, h) (((b) * 2 + (h)) * HTB)
#define PG8_SB(b, h) ((4 + (b) * 2 + (h)) * HTB)
#define PG8_STAGE(bufoff, gbase, voff) do { _Pragma("unroll") for (int _i = 0; _i < 2; ++_i) \
        __builtin_amdgcn_global_load_lds((const unsigned*)((const char*)(gbase) + (voff)[_i]), (PG8_LAS unsigned*)(lds + (bufoff) + ldsw + _i * 8192), 16, 0, 0); } while (0)
#define PG8_LDA(dst, b, h) do { if constexpr (F8) { _Pragma("unroll") for (int m = 0; m < 4; ++m) dst##8[m] = __builtin_shufflevector(*(const PG8_LAS v4i_t*)(lds + PG8_SA(b, h) + aoff + m * 2048), *(const PG8_LAS v4i_t*)(lds + PG8_SA(b, h) + aoff + m * 2048 + 1024), 0, 1, 2, 3, 4, 5, 6, 7); } else { \
        _Pragma("unroll") for (int m = 0; m < 4; ++m) _Pragma("unroll") for (int k = 0; k < 2; ++k) dst[m][k] = *(const PG8_LAS bf16x8*)(lds + PG8_SA(b, h) + aoff + m * 2048 + k * 1024); } } while (0)
#define PG8_LDB(dst, b, h) do { if constexpr (F8) { _Pragma("unroll") for (int n = 0; n < 2; ++n) dst##8[n] = __builtin_shufflevector(*(const PG8_LAS v4i_t*)(lds + PG8_SB(b, h) + boff + n * 2048), *(const PG8_LAS v4i_t*)(lds + PG8_SB(b, h) + boff + n * 2048 + 1024), 0, 1, 2, 3, 4, 5, 6, 7); } else { \
        _Pragma("unroll") for (int n = 0; n < 2; ++n) _Pragma("unroll") for (int k = 0; k < 2; ++k) dst[n][k] = *(const PG8_LAS bf16x8*)(lds + PG8_SB(b, h) + boff + n * 2048 + k * 1024); } } while (0)
#define PG8_MMA(ai, bj, At, Bt) do { __builtin_amdgcn_s_setprio(1); if constexpr (F8) { _Pragma("unroll") for (int m = 0; m < 4; ++m) _Pragma("unroll") for (int n = 0; n < 2; ++n) \
        asm volatile("v_mfma_f32_16x16x128_f8f6f4 %0, %1, %2, %0" : "+v"(acc[ai][bj][m][n]) : "v"(Bt##8[n]), "v"(At##8[m]));     } else { \
        _Pragma("unroll") for (int m = 0; m < 4; ++m) _Pragma("unroll") for (int n = 0; n < 2; ++n) _Pragma("unroll") for (int k = 0; k < 2; ++k) \
        acc[ai][bj][m][n] = __builtin_amdgcn_mfma_f32_16x16x32_bf16(Bt[n][k], At[m][k], acc[ai][bj][m][n], 0, 0, 0); } __builtin_amdgcn_s_setprio(0); } while (0)
#define PG8_WAIT_V(n) asm volatile("s_waitcnt vmcnt(" #n ")" ::: "memory")
#define PG8_WAIT_L(n) asm volatile("s_waitcnt lgkmcnt(" #n ")" ::: "memory")
#define PG8_BAR __builtin_amdgcn_s_barrier()
#define PG8_SCHED __builtin_amdgcn_sched_barrier(0)
    Unit cur, nxt; int ui = 0;
    if (!S.next(0, cur)) return;
    f32x4 acc[2][2][4][2];
#pragma unroll
    for (int a = 0; a < 2; ++a)
#pragma unroll
        for (int b = 0; b < 2; ++b)
#pragma unroll
            for (int m = 0; m < 4; ++m)
#pragma unroll
                for (int n = 0; n < 2; ++n) acc[a][b][m][n] = (f32x4){0.f, 0.f, 0.f, 0.f};
    const int mxone = 0x7f7f7f7f;
    bf16x8 At[4][2], B0[2][2], B1[2][2]; v8i_t At8[4], B08[2], B18[2];
    const char* cA = (const char*)g.A + (size_t)cur.pm * tstep; const char* cB = (const char*)g.Bt + (size_t)cur.pn * tstep;
    S.a_ready(cur);
    if constexpr (SP2) {
        PG8_STAGE(PG8_SB(0, 0), cB, voffB); PG8_STAGE(PG8_SB(0, 1), cB + hstep, voffB); PG8_STAGE(PG8_SA(0, 0), cA, voffA); PG8_STAGE(PG8_SA(0, 1), cA + hstep, voffA);
        if (wr == 1) PG8_BAR;
        PG8_WAIT_V(2); PG8_BAR;
        PG8_STAGE(PG8_SB(1, 0), cB + kstep, voffB); PG8_STAGE(PG8_SA(1, 0), cA + kstep, voffA); PG8_STAGE(PG8_SB(1, 1), cB + hstep + kstep, voffB);
        PG8_WAIT_V(6); PG8_BAR;
    } else {
        PG8_STAGE(PG8_SB(0, 0), cB, voffB); PG8_STAGE(PG8_SA(0, 0), cA, voffA); PG8_STAGE(PG8_SB(0, 1), cB + hstep, voffB); PG8_STAGE(PG8_SA(0, 1), cA + hstep, voffA);
        if (wr == 1) PG8_BAR;
        PG8_WAIT_V(4); PG8_BAR;
        PG8_STAGE(PG8_SB(1, 0), cB + kstep, voffB); PG8_STAGE(PG8_SA(1, 0), cA + kstep, voffA); PG8_STAGE(PG8_SB(1, 1), cB + hstep + kstep, voffB);
        PG8_WAIT_V(6); PG8_BAR;
    }
    for (;;) {
        const bool has_next = S.next(ui + 1, nxt);
        const char* nA = has_next ? (const char*)g.A + (size_t)nxt.pm * tstep : cA; const char* nB = has_next ? (const char*)g.Bt + (size_t)nxt.pn * tstep : cB;
        for (int t = 0; t < nt; t += 2) {
            const bool last = (t == nt - 2);
            const char* a1 = cA + (size_t)(t + 1) * kstep;
            const char* a2 = last ? nA : cA + (size_t)(t + 2) * kstep; const char* b2 = last ? nB : cB + (size_t)(t + 2) * kstep;
            const char* a3 = a2 + kstep; const char* b3 = b2 + kstep;
            if (last && has_next) S.a_ready(nxt);
            if constexpr (SP2) {
            PG8_LDB(B0, 0, 0); PG8_LDB(B1, 0, 1); PG8_SCHED; PG8_LDA(At, 0, 0); PG8_STAGE(PG8_SA(1, 1), a1 + hstep, voffA);
            PG8_WAIT_V(8); PG8_WAIT_L(0); PG8_BAR; PG8_MMA(0, 0, At, B0); PG8_MMA(0, 1, At, B1); PG8_BAR; PG8_SCHED;
            PG8_LDA(At, 0, 1); PG8_STAGE(PG8_SB(0, 0), b2, voffB); PG8_STAGE(PG8_SB(0, 1), b2 + hstep, voffB); PG8_STAGE(PG8_SA(0, 0), a2, voffA);
            PG8_WAIT_V(8); PG8_WAIT_L(0); PG8_BAR; PG8_MMA(1, 0, At, B0); PG8_MMA(1, 1, At, B1); PG8_BAR; PG8_SCHED;
            PG8_LDB(B0, 1, 0); PG8_LDB(B1, 1, 1); PG8_SCHED; PG8_LDA(At, 1, 0); PG8_STAGE(PG8_SA(0, 1), a2 + hstep, voffA);
            PG8_WAIT_V(8); PG8_WAIT_L(0); PG8_BAR; PG8_MMA(0, 0, At, B0); PG8_MMA(0, 1, At, B1); PG8_BAR; PG8_SCHED;
            PG8_LDA(At, 1, 1); PG8_STAGE(PG8_SB(1, 0), b3, voffB); PG8_STAGE(PG8_SB(1, 1), b3 + hstep, voffB); PG8_STAGE(PG8_SA(1, 0), a3, voffA);
            PG8_WAIT_V(8); PG8_WAIT_L(0); PG8_BAR; PG8_MMA(1, 0, At, B0); PG8_MMA(1, 1, At, B1); PG8_BAR; PG8_SCHED;
            } else {
            PG8_LDB(B0, 0, 0); PG8_SCHED; PG8_LDA(At, 0, 0); PG8_STAGE(PG8_SA(1, 1), a1 + hstep, voffA);
            PG8_WAIT_L(8); PG8_BAR; PG8_WAIT_L(0); PG8_MMA(0, 0, At, B0); PG8_BAR; PG8_SCHED;
            PG8_LDB(B1, 0, 1); PG8_STAGE(PG8_SB(0, 0), b2, voffB);
            PG8_BAR; PG8_WAIT_L(0); PG8_MMA(0, 1, At, B1); PG8_BAR;
            PG8_LDA(At, 0, 1); PG8_STAGE(PG8_SA(0, 0), a2, voffA);
            PG8_BAR; PG8_WAIT_L(0); PG8_MMA(1, 0, At, B0); PG8_BAR; PG8_SCHED;
            PG8_STAGE(PG8_SB(0, 1), b2 + hstep, voffB);
            PG8_WAIT_V(6); PG8_BAR; PG8_MMA(1, 1, At, B1); PG8_BAR;
            PG8_LDB(B0, 1, 0); PG8_SCHED; PG8_LDA(At, 1, 0); PG8_STAGE(PG8_SA(0, 1), a2 + hstep, voffA);
            PG8_WAIT_L(8); PG8_BAR; PG8_WAIT_L(0); PG8_MMA(0, 0, At, B0); PG8_BAR; PG8_SCHED;
            PG8_LDB(B1, 1, 1); PG8_STAGE(PG8_SB(1, 0), b3, voffB);
            PG8_BAR; PG8_WAIT_L(0); PG8_MMA(0, 1, At, B1); PG8_BAR;
            PG8_LDA(At, 1, 1); PG8_STAGE(PG8_SA(1, 0), a3, voffA);
            PG8_BAR; PG8_WAIT_L(0); PG8_MMA(1, 0, At, B0); PG8_BAR; PG8_SCHED;
            PG8_STAGE(PG8_SB(1, 1), b3 + hstep, voffB);
            PG8_WAIT_V(6); PG8_BAR; PG8_MMA(1, 1, At, B1); PG8_BAR;
            }
        }
        if constexpr (ALIGN_EPI) { if (wr == 0) PG8_BAR; }
        if constexpr (F8) asm volatile("s_nop 15\n\ts_nop 15" ::: "memory");
        if constexpr (!Epi::AFTER_DRAIN) { E(acc, cur, wr, wc, fr, fq); S.done(cur); }
        if (!has_next) break;
#pragma unroll
        for (int a = 0; a < 2; ++a)
#pragma unroll
            for (int b = 0; b < 2; ++b)
#pragma unroll
                for (int m = 0; m < 4; ++m)
#pragma unroll
                    for (int n = 0; n < 2; ++n) acc[a][b][m][n] = (f32x4){0.f, 0.f, 0.f, 0.f};
        cur = nxt; cA = nA; cB = nB; ++ui;
        if constexpr (ALIGN_EPI) { if (wr == 1) PG8_BAR; }
    }
    PG8_WAIT_V(0);
    if constexpr (!ALIGN_EPI) { if (wr == 0) PG8_BAR; }
    PG8_BAR;
    if constexpr (Epi::AFTER_DRAIN) { E.fused(acc, cur, wr, wc, fr, fq, lds, wid, lane); S.done(cur); }
#undef PG8_SA
#undef PG8_SB
#undef PG8_STAGE
#undef PG8_LDA
#undef PG8_LDB
#undef PG8_MMA
#undef PG8_WAIT_V
#undef PG8_WAIT_L
#undef PG8_BAR
#undef PG8_SCHED
}
}
namespace att {
using bf16 = unsigned short;
constexpr int   D = 128, NW = 8, QBLK = 32, KVBLK = 64;
constexpr float SCALE = 0.088388347648318440f;
constexpr float THR = 2.f;
constexpr float PSC = 32.f, LPSC = 5.f;
constexpr int LDQ = 5120, LDV = 1024, LDO = 4096;
constexpr int KP = 144;
constexpr float QKS = 1.0f / 256.0f;
constexpr size_t SHM_V = KVBLK * D, SHM_K = KVBLK * KP, SHM_ATTN = 2 * SHM_V + 2 * SHM_K + NW * 64 * 4;
constexpr size_t SHM_OST = 68 * 1024;
constexpr size_t SHM_TOTAL = SHM_OST + NW * 8192;
using bf16x8 = __attribute__((ext_vector_type(8))) short;
using s16x4  = __attribute__((ext_vector_type(4))) short;
using f32x16 = __attribute__((ext_vector_type(16))) float;
using u32x4  = __attribute__((ext_vector_type(4))) unsigned;
using v4i_t  = __attribute__((ext_vector_type(4))) int;
using v8i_t  = __attribute__((ext_vector_type(8))) int;
using v2i_t  = __attribute__((ext_vector_type(2))) int;
using f32x2  = __attribute__((ext_vector_type(2))) float;
#define KSWZ(row, colB) ((row) * 256 + ((colB) ^ (((row) & 7) << 4)))
#define SBAR() __builtin_amdgcn_sched_barrier(0)
__device__ __forceinline__ int crow(int r, int hi) { return (r & 3) + 8 * (r >> 2) + 4 * hi; }
__device__ __forceinline__ unsigned cvtpk(float lo, float hi) {
  unsigned r; asm volatile("v_cvt_pk_bf16_f32 %0, %1, %2" : "=v"(r) : "v"(lo), "v"(hi)); return r;
}
__device__ __forceinline__ bf16x8 ld8(const bf16* p) { return *reinterpret_cast<const bf16x8*>(p); }

__device__ __forceinline__ void partialSM(f32x16& p0, f32x16& p1, float& m_reg, float& mn, float& alpha) {
  constexpr float C = SCALE * QKS * 1.4426950408889634f;
  float pmax = p0[0]; for (int r = 1; r < 16; ++r) pmax = fmaxf(pmax, p0[r]); for (int r = 0; r < 16; ++r) pmax = fmaxf(pmax, p1[r]);
  { auto rr = __builtin_amdgcn_permlane32_swap(__float_as_uint(pmax), __float_as_uint(pmax), false, false);
    pmax = fmaxf(__uint_as_float(rr[0]), __uint_as_float(rr[1])); }
  if (__builtin_expect(__all(pmax - m_reg <= THR / (SCALE * QKS)), 1)) { mn = m_reg; alpha = 1.f; }
  else { mn = fmaxf(m_reg, pmax); alpha = __builtin_amdgcn_exp2f((m_reg - mn) * C); m_reg = mn; }
  const float mnC = fmaf(-mn, C, LPSC);
  p0 = p0 * C + mnC; p1 = p1 * C + mnC;
  for (int r = 0; r < 16; ++r) p0[r] = __builtin_amdgcn_exp2f(p0[r]);
}
__device__ __forceinline__ unsigned pk4f8(float a, float b, float c, float d) { int u; asm volatile("" : "=v"(u));   int p = __builtin_amdgcn_cvt_pk_fp8_f32(a, b, u, false); return (unsigned)__builtin_amdgcn_cvt_pk_fp8_f32(c, d, p, true); }
__device__ __forceinline__ float rowsum32(const f32x16& p0, const f32x16& p1) {
  f32x2 sa = {p0[0], p0[1]}, sb = {p0[2], p0[3]};
#pragma unroll
  for (int r = 2; r < 8; r += 2) { sa += (f32x2){p0[2 * r], p0[2 * r + 1]}; sb += (f32x2){p0[2 * r + 2], p0[2 * r + 3]}; }
#pragma unroll
  for (int r = 0; r < 8; r += 2) { sa += (f32x2){p1[2 * r], p1[2 * r + 1]}; sb += (f32x2){p1[2 * r + 2], p1[2 * r + 3]}; }
  sa += sb; return sa[0] + sa[1]; }
__device__ __forceinline__ void finishSM(f32x16& p0, f32x16& p1, float alpha, float& l_reg, v8i_t& pa) {
  for (int r = 0; r < 16; ++r) p1[r] = __builtin_amdgcn_exp2f(p1[r]);
  float ps = rowsum32(p0, p1);
  { auto rr = __builtin_amdgcn_permlane32_swap(__float_as_uint(ps), __float_as_uint(ps), false, false);
    ps = __uint_as_float(rr[0]) + __uint_as_float(rr[1]); }
  l_reg = l_reg * alpha + ps;
#pragma unroll
  for (int d = 0; d < 4; ++d) { const unsigned x0 = pk4f8(p0[4 * d], p0[4 * d + 1], p0[4 * d + 2], p0[4 * d + 3]), x1 = pk4f8(p1[4 * d], p1[4 * d + 1], p1[4 * d + 2], p1[4 * d + 3]);
    auto rr = __builtin_amdgcn_permlane32_swap(x0, x1, false, false); pa[d] = (int)rr[0]; pa[4 + d] = (int)rr[1]; }
}
__device__ __forceinline__ void qkt(f32x16& p0, f32x16& p1, const char* Ks, const v8i_t* qr, int r32, int hi) {
  p0 = f32x16{}; p1 = f32x16{};
  const char* k0 = Ks + r32 * KP + hi * 32;
#pragma unroll
  for (int ks = 0; ks < 2; ++ks) {
    const v8i_t a0 = __builtin_shufflevector(*reinterpret_cast<const v4i_t*>(k0 + ks * 64), *reinterpret_cast<const v4i_t*>(k0 + ks * 64 + 16), 0, 1, 2, 3, 4, 5, 6, 7);
    const v8i_t a1 = __builtin_shufflevector(*reinterpret_cast<const v4i_t*>(k0 + 32 * KP + ks * 64), *reinterpret_cast<const v4i_t*>(k0 + 32 * KP + ks * 64 + 16), 0, 1, 2, 3, 4, 5, 6, 7);
    p0 = __builtin_amdgcn_mfma_scale_f32_32x32x64_f8f6f4(a0, qr[ks], p0, 0, 0, 0, 0, 0, 0);
    p1 = __builtin_amdgcn_mfma_scale_f32_32x32x64_f8f6f4(a1, qr[ks], p1, 0, 0, 0, 0, 0, 0); }
}
__device__ __forceinline__ int vf(int k) { return ((k >> 1) & 1) | (((k >> 3) & 1) << 1); }
template <int OFF> __device__ __forceinline__ v2i_t tr8_read(int vb) {
  v2i_t r; asm volatile("ds_read_b64_tr_b8 %0, %1 offset:%2" : "=&v"(r) : "v"(vb), "i"(OFF) : "memory"); return r;
}
template <int BUFOFF> __device__ __forceinline__ void pv_blk(f32x16& od, int vb, const v8i_t& pa) {
  const v2i_t t0 = tr8_read<BUFOFF>(vb), t1 = tr8_read<BUFOFF + 16 * 128>(vb), t2 = tr8_read<BUFOFF + 4 * 128>(vb), t3 = tr8_read<BUFOFF + 20 * 128>(vb);
  asm volatile("s_waitcnt lgkmcnt(0)" ::: "memory"); SBAR();
  const v8i_t b = {t0[0], t0[1], t1[0], t1[1], t2[0], t2[1], t3[0], t3[1]};
  od = __builtin_amdgcn_mfma_scale_f32_32x32x64_f8f6f4(pa, b, od, 0, 0, 0, 0, 0, 0);
}
template <int BUFOFF> __device__ __forceinline__ void pv_d0(f32x16* o, const int (&vb)[4], const v8i_t& pa) {
  pv_blk<BUFOFF>(o[0], vb[0], pa); pv_blk<BUFOFF>(o[1], vb[1], pa); pv_blk<BUFOFF>(o[2], vb[2], pa); pv_blk<BUFOFF>(o[3], vb[3], pa);
}

#define ATT_LAS __attribute__((address_space(3)))
template <int OFF> __device__ __forceinline__ v8i_t vread(int vb) {
  const v2i_t t0 = __builtin_amdgcn_ds_read_tr8_b64_v2i32((ATT_LAS v2i_t*)(unsigned)(vb + OFF)), t1 = __builtin_amdgcn_ds_read_tr8_b64_v2i32((ATT_LAS v2i_t*)(unsigned)(vb + OFF + 16 * 128)),
              t2 = __builtin_amdgcn_ds_read_tr8_b64_v2i32((ATT_LAS v2i_t*)(unsigned)(vb + OFF + 4 * 128)), t3 = __builtin_amdgcn_ds_read_tr8_b64_v2i32((ATT_LAS v2i_t*)(unsigned)(vb + OFF + 20 * 128));
  return (v8i_t){t0[0], t0[1], t1[0], t1[1], t2[0], t2[1], t3[0], t3[1]};
}
#define ATT_MFMA(a, b, c) __builtin_amdgcn_mfma_scale_f32_32x32x64_f8f6f4(a, b, c, 0, 0, 0, 0, 0, 0)
#define ATT_CAT(x, y) __builtin_shufflevector(x, y, 0, 1, 2, 3, 4, 5, 6, 7)
template <int KOFF, int VOFF>
__device__ __forceinline__ void stepX(f32x16& pc0, f32x16& pc1, float alc, float& l_reg, v8i_t& pa, f32x16& pn0, f32x16& pn1, v8i_t& vA, const char* K_lds, int vb0, const v8i_t* qr, int r32, int hi) {
  const char* k0 = K_lds + KOFF + r32 * KP + hi * 32;
  const v4i_t k00 = *reinterpret_cast<const v4i_t*>(k0), k01 = *reinterpret_cast<const v4i_t*>(k0 + 16), k10 = *reinterpret_cast<const v4i_t*>(k0 + 32 * KP), k11 = *reinterpret_cast<const v4i_t*>(k0 + 32 * KP + 16);
  const v4i_t k20 = *reinterpret_cast<const v4i_t*>(k0 + 64), k21 = *reinterpret_cast<const v4i_t*>(k0 + 80), k30 = *reinterpret_cast<const v4i_t*>(k0 + 32 * KP + 64), k31 = *reinterpret_cast<const v4i_t*>(k0 + 32 * KP + 80);
  vA = vread<VOFF>(vb0);
  SBAR();
#pragma unroll
  for (int r = 0; r < 16; ++r) pc1[r] = __builtin_amdgcn_exp2f(pc1[r]);
  SBAR();
  pn0 = ATT_MFMA(ATT_CAT(k00, k01), qr[0], (f32x16){});
  SBAR();
  float ps = rowsum32(pc0, pc1);
  SBAR();
  pn1 = ATT_MFMA(ATT_CAT(k10, k11), qr[0], (f32x16){});
  SBAR();
  { auto rr = __builtin_amdgcn_permlane32_swap(__float_as_uint(ps), __float_as_uint(ps), false, false); ps = __uint_as_float(rr[0]) + __uint_as_float(rr[1]); }
  l_reg = l_reg * alc + ps;
  unsigned x0[4], x1[4];
#pragma unroll
  for (int d = 0; d < 4; ++d) x0[d] = pk4f8(pc0[4 * d], pc0[4 * d + 1], pc0[4 * d + 2], pc0[4 * d + 3]);
  SBAR();
  pn0 = ATT_MFMA(ATT_CAT(k20, k21), qr[1], pn0);
  SBAR();
#pragma unroll
  for (int d = 0; d < 4; ++d) x1[d] = pk4f8(pc1[4 * d], pc1[4 * d + 1], pc1[4 * d + 2], pc1[4 * d + 3]);
  SBAR();
  pn1 = ATT_MFMA(ATT_CAT(k30, k31), qr[1], pn1);
  SBAR();
#pragma unroll
  for (int d = 0; d < 4; ++d) { auto rr = __builtin_amdgcn_permlane32_swap(x0[d], x1[d], false, false); pa[d] = (int)rr[0]; pa[4 + d] = (int)rr[1]; }
}
template <int VOFF>
__device__ __forceinline__ void stepY(f32x16* o, const v8i_t& pa, v8i_t& vA, const int (&vb)[4], f32x16& pn0, f32x16& pn1, float& m_reg, float& mn, float& alpha) {
  constexpr float C = SCALE * QKS * 1.4426950408889634f;
  v8i_t vB = vread<VOFF>(vb[1]);
  o[0] = ATT_MFMA(pa, vA, o[0]);
  SBAR();
  float pmax = pn0[0];
#pragma unroll
  for (int r = 1; r < 16; ++r) pmax = fmaxf(pmax, pn0[r]);
  SBAR();
  vA = vread<VOFF>(vb[2]);
  o[1] = ATT_MFMA(pa, vB, o[1]);
  SBAR();
#pragma unroll
  for (int r = 0; r < 16; ++r) pmax = fmaxf(pmax, pn1[r]);
  { auto rr = __builtin_amdgcn_permlane32_swap(__float_as_uint(pmax), __float_as_uint(pmax), false, false); pmax = fmaxf(__uint_as_float(rr[0]), __uint_as_float(rr[1])); }
  const bool keep = __all(pmax - m_reg <= THR / (SCALE * QKS));
  mn = keep ? m_reg : fmaxf(m_reg, pmax); alpha = __builtin_amdgcn_exp2f((m_reg - mn) * C); m_reg = mn;
  const float mnC = fmaf(-mn, C, LPSC);
  SBAR();
  vB = vread<VOFF>(vb[3]);
  o[2] = ATT_MFMA(pa, vA, o[2]);
  SBAR();
  pn0 = pn0 * C + mnC; pn1 = pn1 * C + mnC;
  SBAR();
  o[3] = ATT_MFMA(pa, vB, o[3]);
  SBAR();
#pragma unroll
  for (int r = 0; r < 16; ++r) pn0[r] = __builtin_amdgcn_exp2f(pn0[r]);
  asm volatile("" : "+v"(pn0), "+v"(pn1));
}

__device__ __forceinline__ void attn_dense_body(const unsigned char* __restrict__ Qb, const unsigned char* __restrict__ Kh, const unsigned char* __restrict__ Vh,
                                                unsigned char* __restrict__ Ob, int seq, char* lds) {
  const int tid = threadIdx.x, wid = tid >> 6, lane = tid & 63, r32 = lane & 31, hi = lane >> 5;
  char* V_lds = lds; char* K_lds = lds + 2 * SHM_V;
  float* ws = (float*)(lds + 2 * SHM_V + 2 * SHM_K) + wid * 64; float* li_l = ws; float* al_l = ws + 32;
  float m_reg = -1e30f, l_reg = 0; f32x16 o[4] = {}; v8i_t qr[2];
  const unsigned char* Qw = Qb + (long)(wid * QBLK + r32) * LDQ + hi * 32;
#pragma unroll
  for (int ks = 0; ks < 2; ++ks) qr[ks] = __builtin_shufflevector(*reinterpret_cast<const v4i_t*>(Qw + ks * 64), *reinterpret_cast<const v4i_t*>(Qw + ks * 64 + 16), 0, 1, 2, 3, 4, 5, 6, 7);
  const int kkey = tid >> 3, kc = tid & 7, kch = kc * 16, kst = kkey * KP + kch;
  const int vst = kkey * 128 + (((kc >> 1) ^ vf(kkey)) * 32) + (kc & 1) * 16;
  int vb[4];
  { const int i = lane & 15, g = lane >> 4, jj = i >> 1, kb = (jj & 3) + 8 * (jj >> 2) + 32 * (g >> 1), f = ((jj >> 1) & 1) | (((jj >> 2) & 1) << 1);
#pragma unroll
    for (int blk = 0; blk < 4; ++blk) vb[blk] = (int)(uintptr_t)V_lds + kb * 128 + ((blk ^ f) * 32) + (g & 1) * 16 + 8 * (i & 1); }
  struct { v4i_t vs, ks; } sr_[2];
  const unsigned voffV = (unsigned)(kkey * LDV + kch), voffK = (unsigned)(kkey * LDQ + kch);
#define SLOAD(i, k0) do { const unsigned char* vt_ = Vh + (size_t)(k0) * LDV; const unsigned char* kt_ = Kh + (size_t)(k0) * LDQ; \
    sr_[i].vs = *reinterpret_cast<const v4i_t*>(vt_ + voffV); sr_[i].ks = *reinterpret_cast<const v4i_t*>(kt_ + voffK); } while (0)
#define SWRITE(b, i) do { *(v4i_t*)(V_lds + (b) * SHM_V + vst) = sr_[i].vs; *(v4i_t*)(K_lds + (b) * SHM_K + kst) = sr_[i].ks; } while (0)
#define SWAIT() asm volatile("s_waitcnt vmcnt(2)" ::: "memory")
#define RESC(a) do { if (__any((a) < 1.f)) { if (hi == 0) al_l[r32] = (a); asm volatile("s_waitcnt lgkmcnt(0)" ::: "memory"); \
    for (int d = 0; d < 4; ++d) for (int r = 0; r < 16; ++r) o[d][r] *= al_l[crow(r, hi)]; } } while (0)
  f32x16 pA0, pA1, pB0, pB1; float mnA, mnB, alA, alB; v8i_t pa; const int NT = seq / KVBLK;
  constexpr int SE = 0, SO = 1;
  SLOAD(SE, 0); asm volatile("s_waitcnt vmcnt(0)" ::: "memory"); SWRITE(0, SE); __syncthreads();
  qkt(pA0, pA1, K_lds, qr, r32, hi); partialSM(pA0, pA1, m_reg, mnA, alA);
  SLOAD(SO, KVBLK); if (2 < NT) SLOAD(SE, 2 * KVBLK);
  SWAIT(); SWRITE(1, SO); __syncthreads();
  v8i_t vA;
  for (int j = 1; j + 1 < NT; j += 2) {
    SBAR(); stepX<(int)SHM_K, 0>(pA0, pA1, alA, l_reg, pa, pB0, pB1, vA, K_lds, vb[0], qr, r32, hi); SBAR();
    SLOAD(SO, (j + 2) * KVBLK); SBAR();
    stepY<0>(o, pa, vA, vb, pB0, pB1, m_reg, mnB, alB);
    __syncthreads(); SWAIT(); SWRITE(0, SE);
    RESC(alB); __syncthreads();
    SBAR(); stepX<0, (int)SHM_V>(pB0, pB1, alB, l_reg, pa, pA0, pA1, vA, K_lds, vb[0], qr, r32, hi); SBAR();
    SLOAD(SE, (j + 3 < NT ? j + 3 : NT - 1) * KVBLK); SBAR();
    stepY<(int)SHM_V>(o, pa, vA, vb, pA0, pA1, m_reg, mnA, alA);
    __syncthreads(); SWAIT(); SWRITE(1, SO);
    RESC(alA); __syncthreads();
  }
  SBAR(); qkt(pB0, pB1, K_lds + SHM_K, qr, r32, hi);
  finishSM(pA0, pA1, alA, l_reg, pa); SBAR();
  pv_d0<0>(o, vb, pa); partialSM(pB0, pB1, m_reg, mnB, alB);
  __syncthreads(); RESC(alB);
  finishSM(pB0, pB1, alB, l_reg, pa); SBAR();
  pv_d0<(int)SHM_V>(o, vb, pa);
  if (hi == 0) li_l[r32] = l_reg; asm volatile("s_waitcnt lgkmcnt(0)" ::: "memory");
  int tide = tid; asm volatile("" : "+v"(tide));
  const int lanee = tide & 63, wide = tide >> 6, r32e = lanee & 31, hie = lanee >> 5;
  float rli[16];
#pragma unroll
  for (int r = 0; r < 16; ++r) rli[r] = __builtin_amdgcn_rcpf(li_l[crow(r, hi)]);
  char* ost = lds + SHM_OST + wide * 8192 + hie * 512 + r32e;
#pragma unroll
  for (int r = 0; r < 16; ++r) { const float rs = rli[r];
#pragma unroll
    for (int d0 = 0; d0 < 4; ++d0) { const float v = __builtin_amdgcn_fmed3f(o[d0][r] * rs, -448.f, 448.f);
      *(unsigned char*)(ost + ((r & 3) + 8 * (r >> 2)) * 128 + d0 * 32) = (unsigned char)(__builtin_amdgcn_cvt_pk_fp8_f32(v, 0.f, 0, false) & 0xFF); } }
  asm volatile("s_waitcnt lgkmcnt(0)" ::: "memory");
  const char* ord = lds + SHM_OST + wide * 8192 + (lanee >> 3) * 128 + (lanee & 7) * 16;
  unsigned char* Ow = Ob + (long)(wide * QBLK + (lanee >> 3)) * LDO + (lanee & 7) * 16;
#pragma unroll
  for (int i = 0; i < 4; ++i) { const u32x4 w = *(const u32x4*)(ord + i * 1024); *(u32x4*)(Ow + (long)i * 8 * LDO) = w; }
#undef SLOAD
#undef SWRITE
#undef SWAIT
#undef RESC
}
#undef KSWZ
#undef SBAR
}
#ifndef SELNET_HD
#define SELNET_HD __device__ __forceinline__
#endif
namespace seln {
SELNET_HD void ce(float& a, float& b) { const float mx = fmaxf(a, b), mn = fminf(a, b); a = mx; b = mn; }
SELNET_HD void sort16(float (&v)[16]) {
#pragma unroll
    for (int k = 2; k <= 16; k <<= 1) {
#pragma unroll
        for (int j = k >> 1; j > 0; j >>= 1) {
#pragma unroll
            for (int i = 0; i < 16; ++i) { const int l = i ^ j; if (l > i) { if ((i & k) == 0) ce(v[i], v[l]); else ce(v[l], v[i]); } }
        }
    }
}
SELNET_HD void merge16(float (&a)[16], const float (&b)[16]) {
#pragma unroll
    for (int i = 0; i < 16; ++i) a[i] = fmaxf(a[i], b[15 - i]);
#pragma unroll
    for (int j = 8; j > 0; j >>= 1) {
#pragma unroll
        for (int i = 0; i < 16; ++i) { const int l = i ^ j; if (l > i) ce(a[i], a[l]); }
    }
}
SELNET_HD void top16_of_64(float (&v)[4][16]) {
    sort16(v[0]); sort16(v[1]); sort16(v[2]); sort16(v[3]);
    merge16(v[0], v[1]); merge16(v[2], v[3]); merge16(v[0], v[2]);
}
}
constexpr int NWAVES = 8;
#ifndef MK_PER_PHASE
#define MK_PER_PHASE 0
#endif
constexpr int BATCH = 4, SEQ = 4096, DM = 4096, T = BATCH * SEQ, QKVD = 6144, CIN = 3 * DM, PQD = 2048, NEXP = 16384, SLOTS = 128;
constexpr float EPS = 1e-6f;
constexpr size_t MiB = 1u << 20;
constexpr size_t WS_CTL = 0, CTL_ZERO_BYTES = 1 * MiB;
constexpr size_t WS_WQKV = 1 * MiB;
constexpr size_t WS_WO   = WS_WQKV + 48 * MiB;
constexpr size_t WS_WIN  = WS_WO + 32 * MiB;
constexpr size_t WS_WOUT = WS_WIN + 96 * MiB;
constexpr size_t WS_WPQ  = WS_WOUT + 32 * MiB;
constexpr size_t WS_SK   = WS_WPQ + 32 * MiB;
constexpr size_t WS_ROPE = WS_SK + 1 * MiB;
constexpr size_t WS_ISC  = WS_ROPE + 65536;
constexpr size_t WS_U    = WS_ROPE + 1 * MiB;
constexpr size_t WS_V    = WS_U + 128 * MiB;
constexpr size_t WS_HN   = WS_V + 128 * MiB;
constexpr size_t WS_QKV  = WS_HN + 128 * MiB;
constexpr size_t WS_O    = WS_QKV + 192 * MiB;
constexpr size_t WS_PQ   = WS_O + 128 * MiB;
constexpr size_t WS_IDX  = WS_PQ + 64 * MiB;
constexpr size_t WS_GATE = WS_IDX + 8 * MiB;
constexpr size_t WS_BCX  = WS_GATE + 8 * MiB;
constexpr size_t WS_Y    = WS_BCX + 384 * MiB;
constexpr size_t WS_PART = WS_Y + 128 * MiB;
constexpr size_t WS_WQ8  = WS_PART + 128 * MiB;
constexpr size_t WS_END  = WS_WQ8 + 8 * MiB;
constexpr int CW_TMO = 0, CW_BAR = 4096, CW_RANK = 8192, CW_AMAX = 12288;
constexpr int RING_OFF = 0, RING_BYTES = 135168;
constexpr int MISC_OFF = RING_BYTES;
constexpr int VL_OFF = MISC_OFF + 256, VL_WAVE = 2560;
constexpr int LDS_BYTES = 159744;
static_assert(VL_OFF + NWAVES * VL_WAVE <= LDS_BYTES && MISC_OFF + 128 <= LDS_BYTES && (int)att::SHM_TOTAL <= RING_BYTES && pg8::STAGE_BYTES <= RING_BYTES, "LDS map");

#define GAS __attribute__((address_space(1)))
#define LAS __attribute__((address_space(3)))
typedef unsigned short bf16;
typedef unsigned v4u __attribute__((ext_vector_type(4)));
typedef unsigned v2u __attribute__((ext_vector_type(2)));
typedef int v4i __attribute__((ext_vector_type(4)));
typedef float f32x4 __attribute__((ext_vector_type(4)));
typedef float f32x16 __attribute__((ext_vector_type(16)));
typedef short bf16x8 __attribute__((ext_vector_type(8)));
typedef __bf16 bf16x2 __attribute__((ext_vector_type(2)));
typedef GAS unsigned gu32;
#define RLX_AGENT __ATOMIC_RELAXED, __HIP_MEMORY_SCOPE_AGENT
#define LDS_WAIT() asm volatile("s_waitcnt lgkmcnt(0)" ::: "memory")
#define VM_WAIT() asm volatile("s_waitcnt vmcnt(0)" ::: "memory")
__device__ __forceinline__ unsigned f2bf(float f) { unsigned u = __builtin_bit_cast(unsigned, f); return (u + 0x7fffu + ((u >> 16) & 1u)) >> 16; }
__device__ __forceinline__ unsigned pk2(float lo, float hi) { return f2bf(lo) | (f2bf(hi) << 16); }
__device__ __forceinline__ float bflo(unsigned w) { return __uint_as_float(w << 16); }
__device__ __forceinline__ float bfhi(unsigned w) { return __uint_as_float(w & 0xffff0000u); }
__device__ __forceinline__ float dot2(unsigned a, unsigned b, float acc) { return __builtin_amdgcn_fdot2_f32_bf16(__builtin_bit_cast(bf16x2, a), __builtin_bit_cast(bf16x2, b), acc, false); }
__device__ __forceinline__ float wave_sum(float v) {
#pragma unroll
    for (int o = 1; o < 64; o <<= 1) v += __shfl_xor(v, o);
    return v;
}

#define XB_TMO      128
#define XB_XCNT(j)  (256  + 64 * (j))
#define XB_XSUB(j)  (1280 + 64 * (j))
#define XB_XGEN(j)  (2304 + 64 * (j))
#define XB_TOP      3328
#define XB_TOPGEN   3392
#define XCD_BAR_WORDS 3456
#define XB_SPIN_CAP (1u << 18)

__device__ __forceinline__ unsigned xb_ld(unsigned* p)              { return __hip_atomic_load(p, __ATOMIC_RELAXED, __HIP_MEMORY_SCOPE_AGENT); }
__device__ __forceinline__ unsigned xb_add(unsigned* p, unsigned v) { return __hip_atomic_fetch_add(p, v, __ATOMIC_RELAXED, __HIP_MEMORY_SCOPE_AGENT); }
__device__ __forceinline__ unsigned xb_xcc_id() { return (unsigned)__builtin_amdgcn_s_getreg((3 << 11) | 20) & 0xFu; }
#define XB_SPIN(cond, bar) do { unsigned _sp = 0; while (cond) { __builtin_amdgcn_s_sleep(1); \
    if ((++_sp & 255u) == 0u) { if (xb_ld(&(bar)[XB_TMO])) break; if (_sp > XB_SPIN_CAP) { atomicAdd(&(bar)[XB_TMO], 1u); break; } } } } while (0)

struct XcdBarrier {
    unsigned* bar; unsigned x;
    volatile LAS unsigned* st;
};

__device__ __forceinline__ XcdBarrier xcd_barrier_post(unsigned* bar, volatile LAS unsigned* st) {
    XcdBarrier b; b.bar = bar; b.x = xb_xcc_id(); b.st = st;
    if (threadIdx.x == 0) (void)xb_add(&bar[XB_XCNT(b.x)], 1u);
    return b;
}
__device__ __forceinline__ void xcd_barrier_complete(unsigned* bar, unsigned x, unsigned& nloc, unsigned& nx) {
    const unsigned G = gridDim.x * gridDim.y * gridDim.z;
    unsigned sum, cnt, mine, sp = 0u;
    for (;;) {
        sum = 0u; cnt = 0u; mine = 0u;
#pragma unroll
        for (unsigned j = 0; j < 16; ++j) { const unsigned c = xb_ld(&bar[XB_XCNT(j)]); sum += c; cnt += (c > 0u) ? 1u : 0u; mine = (j == x) ? c : mine; }
        if (sum == G) break;
        __builtin_amdgcn_s_sleep(1);
        if ((++sp & 255u) == 0u) { if (xb_ld(&bar[XB_TMO])) break; if (sp > XB_SPIN_CAP) { atomicAdd(&bar[XB_TMO], 1u); break; } }
    }
    nloc = mine > 0u ? mine : 1u; nx = cnt > 0u ? cnt : 1u;
}

__device__ __forceinline__ void xcd_barrier(const XcdBarrier& b) {
    asm volatile("s_waitcnt vmcnt(0)" ::: "memory");
    __syncthreads();
    if (threadIdx.x == 0) {
        unsigned* bar = b.bar;
        __builtin_amdgcn_s_waitcnt(0);
        unsigned nloc = b.st[0], nx = b.st[1];
        if (nloc == 0u) { xcd_barrier_complete(bar, b.x, nloc, nx); b.st[0] = nloc; b.st[1] = nx; }
        const unsigned old = xb_add(&bar[XB_XSUB(b.x)], 1u);
        const unsigned gen = old / nloc;
        if (old + 1u == (gen + 1u) * nloc) {
            __builtin_amdgcn_fence(__ATOMIC_RELEASE, "agent");
            asm volatile("s_waitcnt vmcnt(0)" ::: "memory");
            const unsigned og = xb_add(&bar[XB_TOP], 1u);
            const unsigned tg = og / nx;
            if (og + 1u == (tg + 1u) * nx) xb_add(&bar[XB_TOPGEN], 1u);
            else XB_SPIN(xb_ld(&bar[XB_TOPGEN]) == tg, bar);
            __builtin_amdgcn_fence(__ATOMIC_ACQUIRE, "agent");
            xb_add(&bar[XB_XGEN(b.x)], 1u);
            asm volatile("s_waitcnt vmcnt(0)" ::: "memory");
        } else {
            XB_SPIN(xb_ld(&bar[XB_XGEN(b.x)]) == gen, bar);
            __builtin_amdgcn_fence(__ATOMIC_ACQUIRE, "agent");
            asm volatile("s_waitcnt vmcnt(0)" ::: "memory");
        }
    }
    __syncthreads();
}

typedef float f32x2 __attribute__((ext_vector_type(2)));
typedef int v2i __attribute__((ext_vector_type(2)));
struct Frame { LAS unsigned char* lds; int tid, lane, wave, vcu, G, gw, NGW; };

__device__ __forceinline__ unsigned pack4_fp8(float a, float b, float c, float d) {
    int p = __builtin_amdgcn_cvt_pk_fp8_f32(__builtin_amdgcn_fmed3f(a, -448.f, 448.f), __builtin_amdgcn_fmed3f(b, -448.f, 448.f), 0, false);
    p = __builtin_amdgcn_cvt_pk_fp8_f32(__builtin_amdgcn_fmed3f(c, -448.f, 448.f), __builtin_amdgcn_fmed3f(d, -448.f, 448.f), p, true); return (unsigned)p;
}
__device__ __forceinline__ void amax_tensor(const Frame& F, const float* src, size_t n4, gu32* word) {
    float mx = 0.f; const size_t stride = (size_t)F.NGW * 64;
    for (size_t i = (size_t)F.gw * 64 + F.lane; i < n4; i += stride) { const f32x4 a = ((const GAS f32x4*)src)[i]; mx = fmaxf(mx, fmaxf(fmaxf(fabsf(a.x), fabsf(a.y)), fmaxf(fabsf(a.z), fabsf(a.w)))); }
#pragma unroll
    for (int o = 1; o < 64; o <<= 1) mx = fmaxf(mx, __shfl_xor(mx, o));
    if (F.lane == 0) __hip_atomic_fetch_max(word, __float_as_uint(mx), RLX_AGENT);
}
__device__ __forceinline__ f32x2 pow2_scale(unsigned amax_bits) { const int E = (int)((amax_bits >> 23) & 0xFFu);
    f32x2 r; r.x = (E == 0 || E > 250) ? 1.0f : __uint_as_float((unsigned)(261 - E) << 23); r.y = (E == 0 || E > 250) ? 1.0f : __uint_as_float((unsigned)(E - 7) << 23); return r; }
__device__ __forceinline__ void rms_row_to_fp8(const float* xrow, const float* gain, unsigned char* orow, int lane) {
    const GAS f32x4* xr = (const GAS f32x4*)xrow + lane;
    f32x4 v[16]; float s = 0.f;
#pragma unroll
    for (int j = 0; j < 16; ++j) { v[j] = xr[64 * j]; s += (v[j].x * v[j].x + v[j].y * v[j].y) + (v[j].z * v[j].z + v[j].w * v[j].w); }
    const float r = 16.0f / sqrtf(wave_sum(s) * (1.f / DM) + EPS);
    const GAS f32x4* gr = (const GAS f32x4*)gain + lane; GAS unsigned* o4 = (GAS unsigned*)orow + lane;
#pragma unroll
    for (int j = 0; j < 16; ++j) { const f32x4 g = gr[64 * j]; o4[64 * j] = pack4_fp8(v[j].x * r * g.x, v[j].y * r * g.y, v[j].z * r * g.z, v[j].w * r * g.w); }
}
__device__ __forceinline__ int convin_row(int n) { return n < DM ? n : (n < 2 * DM ? DM + ((n - DM) >> 7) * 256 + ((n - DM) & 127) : DM + ((n - 2 * DM) >> 7) * 256 + 128 + ((n - 2 * DM) & 127)); }
template <bool REMAP, bool F8>
__device__ __forceinline__ void p0_transpose_item(const float* W, int K, int N, void* WTv, LAS float* scr, int item, int lane, float sc, const float* gk) {
    const int nblk = N / 64, kb = item / nblk, nb = item % nblk, k0 = 64 * kb, n0 = 64 * nb;
    const int kr = lane >> 4, nc = lane & 15;
#pragma unroll 4
    for (int i = 0; i < 16; ++i) { const int kk = kr + 4 * i; f32x4 v = *(const GAS f32x4*)(W + (size_t)(k0 + kk) * N + n0 + 4 * nc);
        if (gk) v = v * gk[k0 + kk];
        LAS float* d = scr + kk * 65 + 4 * nc; d[0] = v.x; d[1] = v.y; d[2] = v.z; d[3] = v.w; }
    LDS_WAIT(); asm volatile("" ::: "memory");
    const int c = lane & 7;
#pragma unroll
    for (int j = 0; j < 8; ++j) { const int n = (lane >> 3) + 8 * j; const LAS float* s = scr + (8 * c) * 65 + n; const int orow = REMAP ? convin_row(n0 + n) : (n0 + n);
        if constexpr (F8) { v2u o; o.x = pack4_fp8(s[0 * 65] * sc, s[1 * 65] * sc, s[2 * 65] * sc, s[3 * 65] * sc); o.y = pack4_fp8(s[4 * 65] * sc, s[5 * 65] * sc, s[6 * 65] * sc, s[7 * 65] * sc);
            *(GAS v2u*)((unsigned char*)WTv + (size_t)orow * K + k0 + 8 * c) = o; }
        else { v4u o; o.x = pk2(s[0 * 65], s[1 * 65]); o.y = pk2(s[2 * 65], s[3 * 65]); o.z = pk2(s[4 * 65], s[5 * 65]); o.w = pk2(s[6 * 65], s[7 * 65]);
            *(GAS v4u*)((bf16*)WTv + (size_t)orow * K + k0 + 8 * c) = o; } }
    LDS_WAIT(); asm volatile("" ::: "memory");
}
template <bool REMAP = false, bool F8 = false>
__device__ __forceinline__ void transpose_all(const Frame& F, const float* W, int K, int N, void* WT, float sc = 1.f, const float* gk = nullptr) {
    LAS float* scr = (LAS float*)(F.lds + RING_OFF + F.wave * 16640);
    const int nitems = (K / 64) * (N / 64);
    for (int it = F.gw; it < nitems; it += F.NGW) p0_transpose_item<REMAP, F8>(W, K, N, WT, scr, it, F.lane, sc, gk);
}
__device__ __forceinline__ void cvt_copy(const Frame& F, const float* src, bf16* dst, size_t n8) {
    const size_t stride = (size_t)F.NGW * 64;
    for (size_t i = (size_t)F.gw * 64 + F.lane; i < n8; i += stride) {
        const f32x4 a = ((const GAS f32x4*)src)[2 * i], b = ((const GAS f32x4*)src)[2 * i + 1];
        v4u o; o.x = pk2(a.x, a.y); o.y = pk2(a.z, a.w); o.z = pk2(b.x, b.y); o.w = pk2(b.z, b.w);
        ((GAS v4u*)dst)[i] = o; }
}
__device__ __forceinline__ void cvt_rows_fp8(const Frame& F, const float* src, unsigned char* dst, float* iscale, int nrows) {
    for (int m = F.gw; m < nrows; m += F.NGW) {
        const GAS f32x4* sp = (const GAS f32x4*)(src + (size_t)m * DM + F.lane * 16);
        f32x4 v[4][4]; float mx = 0.f;
#pragma unroll
        for (int jj = 0; jj < 4; ++jj)
#pragma unroll
            for (int q = 0; q < 4; ++q) { v[jj][q] = sp[jj * 256 + q]; mx = fmaxf(mx, fmaxf(fmaxf(fabsf(v[jj][q].x), fabsf(v[jj][q].y)), fmaxf(fabsf(v[jj][q].z), fabsf(v[jj][q].w)))); }
#pragma unroll
        for (int o = 1; o < 64; o <<= 1) mx = fmaxf(mx, __shfl_xor(mx, o));
        const int E = (int)((__float_as_uint(mx) >> 23) & 0xFFu);
        const float sc = (E == 0 || E > 250) ? 1.0f : __uint_as_float((unsigned)(261 - E) << 23), isc = (E == 0 || E > 250) ? 1.0f : __uint_as_float((unsigned)(E - 7) << 23);
        GAS v4u* dp = (GAS v4u*)(dst + (size_t)m * DM + F.lane * 16);
#pragma unroll
        for (int jj = 0; jj < 4; ++jj) { v4u o;
#pragma unroll
            for (int q = 0; q < 4; ++q) { int pk = __builtin_amdgcn_cvt_pk_fp8_f32(v[jj][q].x * sc, v[jj][q].y * sc, 0, false); pk = __builtin_amdgcn_cvt_pk_fp8_f32(v[jj][q].z * sc, v[jj][q].w * sc, pk, true); o[q] = (unsigned)pk; }
            dp[jj * 64] = o; }
        if (F.lane == 0) iscale[m] = isc;
    }
}
template <bool PAIRED>
__device__ __forceinline__ void cvt_rows_fp4(const Frame& F, const float* src, unsigned char* dst, float* iscale, int nrows) {
    for (int m = F.gw; m < nrows; m += F.NGW) {
        const int l0 = PAIRED ? ((F.lane >> 1) * 32 + (F.lane & 1) * 8) : F.lane * 16;
        const GAS f32x4* sp = (const GAS f32x4*)(src + (size_t)m * DM + l0);
        f32x4 v[4][4]; float mx = 0.f;
#pragma unroll
        for (int jj = 0; jj < 4; ++jj)
#pragma unroll
            for (int q = 0; q < 4; ++q) { v[jj][q] = sp[jj * 256 + (PAIRED ? ((q & 1) + 4 * (q >> 1)) : q)]; mx = fmaxf(mx, fmaxf(fmaxf(fabsf(v[jj][q].x), fabsf(v[jj][q].y)), fmaxf(fabsf(v[jj][q].z), fabsf(v[jj][q].w)))); }
#pragma unroll
        for (int o = 1; o < 64; o <<= 1) mx = fmaxf(mx, __shfl_xor(mx, o));
        const int E = (int)((__float_as_uint(mx) >> 23) & 0xFFu);
        const float sc = (E < 8 || E > 250) ? 1.0f : __uint_as_float((unsigned)(256 - E) << 23), isc = (E < 8 || E > 250) ? 1.0f : __uint_as_float((unsigned)(E - 2) << 23);
        GAS v2u* dp = (GAS v2u*)(dst + (size_t)(m / NEXP) * ((size_t)NEXP * (DM / 2)) + (size_t)(F.lane >> 5) * ((size_t)NEXP * 256) + (size_t)(m % NEXP) * 256 + (F.lane & 31) * 8);
#pragma unroll
        for (int jj = 0; jj < 4; ++jj) { float e[16];
#pragma unroll
            for (int q = 0; q < 4; ++q) { e[4 * q] = __builtin_amdgcn_fmed3f(v[jj][q].x * sc, -6.f, 6.f); e[4 * q + 1] = __builtin_amdgcn_fmed3f(v[jj][q].y * sc, -6.f, 6.f); e[4 * q + 2] = __builtin_amdgcn_fmed3f(v[jj][q].z * sc, -6.f, 6.f); e[4 * q + 3] = __builtin_amdgcn_fmed3f(v[jj][q].w * sc, -6.f, 6.f); }
            v2u o; unsigned w = 0u;
#define F4B(B, SEL) w = __builtin_amdgcn_cvt_scalef32_pk_fp4_f32(w, PAIRED ? e[(B)] : e[2 * (B)], PAIRED ? e[8 + (B)] : e[2 * (B) + 1], 1.0f, SEL)
            F4B(0, 0); F4B(1, 1); F4B(2, 2); F4B(3, 3); o.x = w; w = 0u; F4B(4, 0); F4B(5, 1); F4B(6, 2); F4B(7, 3); o.y = w;
#undef F4B
            dp[(size_t)jj * (2 * NEXP * 256 / 8)] = o; }
        if (F.lane == 0) iscale[m] = isc;
    }
}
__device__ __forceinline__ void rms_row_to_bf16(const float* xrow, const float* gain, bf16* orow, int lane) {
    const GAS f32x4* xr = (const GAS f32x4*)xrow + lane;
    f32x4 v[16]; float s = 0.f;
#pragma unroll
    for (int j = 0; j < 16; ++j) { v[j] = xr[64 * j]; s += (v[j].x * v[j].x + v[j].y * v[j].y) + (v[j].z * v[j].z + v[j].w * v[j].w); }
    const float r = 1.0f / sqrtf(wave_sum(s) * (1.f / DM) + EPS);
    const GAS f32x4* gr = (const GAS f32x4*)gain + lane; GAS v2u* o8 = (GAS v2u*)orow + lane;
#pragma unroll
    for (int j = 0; j < 16; ++j) { const f32x4 g = gr[64 * j]; v2u o; o.x = pk2(v[j].x * r * g.x, v[j].y * r * g.y); o.y = pk2(v[j].z * r * g.z, v[j].w * r * g.w); o8[64 * j] = o; }
}
__device__ __forceinline__ void norm_phase(const Frame& F, const float* src, const float* gain, bf16* dst) {
    for (int m = F.gw; m < T; m += F.NGW) rms_row_to_bf16(src + (size_t)m * DM, gain, dst + (size_t)m * DM, F.lane);
}
__device__ __forceinline__ void norm_phase_x8(const Frame& F, const float* src, const float* gain, bf16* dst, unsigned char* xh, unsigned char* xl) {
    for (int m = F.gw; m < T; m += F.NGW) {
        const GAS f32x4* xr = (const GAS f32x4*)(src + (size_t)m * DM) + F.lane;
        f32x4 v[16]; float s = 0.f;
#pragma unroll
        for (int j = 0; j < 16; ++j) { v[j] = xr[64 * j]; s += (v[j].x * v[j].x + v[j].y * v[j].y) + (v[j].z * v[j].z + v[j].w * v[j].w); }
        const float r = 1.0f / sqrtf(wave_sum(s) * (1.f / DM) + EPS);
        const GAS f32x4* gr = (const GAS f32x4*)gain + F.lane; GAS v2u* o8 = (GAS v2u*)(dst + (size_t)m * DM) + F.lane;
        GAS unsigned* oh = (GAS unsigned*)(xh + (size_t)m * DM) + F.lane; (void)xl;
#pragma unroll
        for (int j = 0; j < 16; ++j) { const f32x4 g = gr[64 * j]; const float a0 = v[j].x * r * g.x, a1 = v[j].y * r * g.y, a2 = v[j].z * r * g.z, a3 = v[j].w * r * g.w;
            v2u o; o.x = pk2(a0, a1); o.y = pk2(a2, a3); o8[64 * j] = o;
            const unsigned hh = pack4_fp8(16.f * a0, 16.f * a1, 16.f * a2, 16.f * a3);
            oh[64 * j] = hh; }
    }
}
__device__ __forceinline__ void norm_row_b(const bf16* xrow, int lane, f32x4 (&v)[8][2], float& r) {
    const GAS v4u* xr = (const GAS v4u*)xrow + lane; float s = 0.f;
#pragma unroll
    for (int j = 0; j < 8; ++j) { const v4u w = xr[64 * j]; v[j][0] = (f32x4){bflo(w.x), bfhi(w.x), bflo(w.y), bfhi(w.y)}; v[j][1] = (f32x4){bflo(w.z), bfhi(w.z), bflo(w.w), bfhi(w.w)};
        s += (v[j][0].x * v[j][0].x + v[j][0].y * v[j][0].y) + (v[j][0].z * v[j][0].z + v[j][0].w * v[j][0].w) + (v[j][1].x * v[j][1].x + v[j][1].y * v[j][1].y) + (v[j][1].z * v[j][1].z + v[j][1].w * v[j][1].w); }
    r = 1.0f / sqrtf(wave_sum(s) * (1.f / DM) + EPS);
}
template <bool X8>
__device__ __forceinline__ void norm_phase_b(const Frame& F, const bf16* src, const float* gain, float* rs, unsigned char* xh) {
    for (int m = F.gw; m < T; m += F.NGW) {
        f32x4 v[8][2]; float r; norm_row_b(src + (size_t)m * DM, F.lane, v, r);
        if (F.lane == 0) rs[m] = r;
        if constexpr (X8) { const GAS f32x4* gr = (const GAS f32x4*)gain + 2 * F.lane; GAS v2u* oh = (GAS v2u*)(xh + (size_t)m * DM) + F.lane; const float r16 = 16.f * r;
#pragma unroll
            for (int j = 0; j < 8; ++j) { const f32x4 g0 = gr[128 * j], g1 = gr[128 * j + 1];
                v2u h8; h8.x = pack4_fp8(v[j][0].x * r16 * g0.x, v[j][0].y * r16 * g0.y, v[j][0].z * r16 * g0.z, v[j][0].w * r16 * g0.w); h8.y = pack4_fp8(v[j][1].x * r16 * g1.x, v[j][1].y * r16 * g1.y, v[j][1].z * r16 * g1.z, v[j][1].w * r16 * g1.w);
                oh[64 * j] = h8; } }
    }
}
__device__ __forceinline__ void rope_table(const Frame& F, float* tab) {
    for (int e = F.tid; e < 2048; e += NWAVES * 64) {
        const int idx = e >> 5, f = e & 31;
        const float inv = powf(10000.0f, -(float)(2 * f) / 64.0f);
        const float angf = (float)idx * inv;
        double x = (double)angf; const double k = rint(x * 0.15915494309189535); x -= k * 6.283185307179586477;
        const double x2 = x * x; double cs = 1.0, sn = x, tc = 1.0, ts = x;
#pragma unroll 1
        for (int n = 1; n <= 16; ++n) { tc *= -x2 / (double)((2 * n - 1) * (2 * n)); ts *= -x2 / (double)((2 * n) * (2 * n + 1)); cs += tc; sn += ts; }
        tab[e] = (float)cs; tab[2048 + e] = (float)sn; }
}

__device__ __forceinline__ void qknorm_rope_phase(const Frame& F, const bf16* qkv, unsigned char* qk8, unsigned char* v8, const float* qg, const float* kg, const float* tab, gu32* vmax_word) {
    { const float sv = pow2_scale(__hip_atomic_load(vmax_word, RLX_AGENT)).x;
      for (int m = F.gw; m < T; m += F.NGW) { const GAS v4u* vp = (const GAS v4u*)(qkv + (size_t)m * QKVD + 5120 + F.lane * 16); const v4u a = vp[0], b = vp[1];
          v4u o; o.x = pack4_fp8(bflo(a.x) * sv, bfhi(a.x) * sv, bflo(a.y) * sv, bfhi(a.y) * sv); o.y = pack4_fp8(bflo(a.z) * sv, bfhi(a.z) * sv, bflo(a.w) * sv, bfhi(a.w) * sv);
          o.z = pack4_fp8(bflo(b.x) * sv, bfhi(b.x) * sv, bflo(b.y) * sv, bfhi(b.y) * sv); o.w = pack4_fp8(bflo(b.z) * sv, bfhi(b.z) * sv, bflo(b.w) * sv, bfhi(b.w) * sv);
          *(GAS v4u*)(v8 + (size_t)m * 1024 + F.lane * 16) = o; } }
    const int lane = F.lane, hh = lane >> 3, sub = lane & 7, axis = sub >> 2, f0 = (sub & 3) * 8;
    for (int it = F.gw; it < T * 5; it += F.NGW) {
        const int t = it / 5, grp = it - t * 5, head = grp * 8 + hh;
        const bf16* p1 = qkv + (size_t)t * QKVD + head * 128 + axis * 64 + f0; const bf16* p2 = p1 + 32;
        const v4u a = *(const GAS v4u*)p1, b = *(const GAS v4u*)p2;
        float x1[8] = {bflo(a.x), bfhi(a.x), bflo(a.y), bfhi(a.y), bflo(a.z), bfhi(a.z), bflo(a.w), bfhi(a.w)};
        float x2[8] = {bflo(b.x), bfhi(b.x), bflo(b.y), bfhi(b.y), bflo(b.z), bfhi(b.z), bflo(b.w), bfhi(b.w)};
        float ss = 0.f;
#pragma unroll
        for (int i = 0; i < 8; ++i) ss += x1[i] * x1[i] + x2[i] * x2[i];
        ss += __shfl_xor(ss, 1); ss += __shfl_xor(ss, 2); ss += __shfl_xor(ss, 4);
        const float r = 1.0f / sqrtf(ss * (1.f / 128.f) + EPS);
        const float* g = (head < 32 ? qg : kg) + axis * 64 + f0;
        const int s = t & (SEQ - 1), idx = axis ? (s & 63) : (s >> 6);
        const float* ct = tab + idx * 32 + f0; const float* st = ct + 2048;
        float o1[8], o2[8];
#pragma unroll
        for (int i = 0; i < 8; ++i) { const float y1 = x1[i] * r * g[i], y2 = x2[i] * r * g[32 + i], c = ct[i], sn = st[i]; o1[i] = y1 * c - y2 * sn; o2[i] = y2 * c + y1 * sn; }
        v2u w1, w2; w1.x = pack4_fp8(16.f * o1[0], 16.f * o1[1], 16.f * o1[2], 16.f * o1[3]); w1.y = pack4_fp8(16.f * o1[4], 16.f * o1[5], 16.f * o1[6], 16.f * o1[7]);
        w2.x = pack4_fp8(16.f * o2[0], 16.f * o2[1], 16.f * o2[2], 16.f * o2[3]); w2.y = pack4_fp8(16.f * o2[4], 16.f * o2[5], 16.f * o2[6], 16.f * o2[7]);
        unsigned char* q1 = qk8 + (size_t)t * 5120 + head * 128 + axis * 64 + f0; *(GAS v2u*)q1 = w1; *(GAS v2u*)(q1 + 32) = w2;
    }
}

__device__ __forceinline__ void attention_phase(const Frame& F, const unsigned char* qk8, const unsigned char* v8, unsigned char* o, char* lds) {
    for (int u = F.vcu; u < 2048; u += F.G) {
        const int bk = u >> 6, rem = u & 63, g = rem >> 4, qb = rem & 15, b = bk >> 3, kvh = bk & 7, h = kvh * 4 + g;
        const size_t row0 = (size_t)b * SEQ;
        const unsigned char* Qb = qk8 + (row0 + qb * 256) * 5120 + h * 128;
        const unsigned char* Kh = qk8 + row0 * 5120 + 4096 + kvh * 128;
        const unsigned char* Vh = v8 + row0 * 1024 + kvh * 128;
        unsigned char* Ob = o + (row0 + qb * 256) * DM + h * 128;
        att::attn_dense_body(Qb, Kh, Vh, Ob, SEQ, lds);
    }
}

__device__ __forceinline__ float pk7(float v, int idx) { return __uint_as_float((__float_as_uint(v) & ~0x7Fu) | (unsigned)idx); }
__device__ __forceinline__ float pk8(float v, unsigned code) { return __uint_as_float((__float_as_uint(v) & ~0xFFu) | code); }
__device__ __forceinline__ void select_half(float (&L)[16], const bf16* qrow  , const bf16* skhp  , int hi) {
    bf16x8 qf[8];
#pragma unroll
    for (int d0 = 0; d0 < 8; ++d0) qf[d0] = *(const GAS bf16x8*)(qrow + d0 * 16);
    float v[4][16];
#pragma unroll
    for (int kt = 0; kt < 4; ++kt) {
        f32x16 acc = {};
        const bf16* kb = skhp + kt * 32 * 128; asm volatile("" : "+v"(kb));
#pragma unroll
        for (int d0 = 0; d0 < 8; ++d0) { const bf16x8 kf = *(const GAS bf16x8*)(kb + d0 * 16); acc = __builtin_amdgcn_mfma_f32_32x32x16_bf16(kf, qf[d0], acc, 0, 0, 0); }
#pragma unroll
        for (int r = 0; r < 16; ++r) v[kt][r] = pk7(acc[r], (kt * 32 + (r & 3) + 8 * (r >> 2)) | (hi << 2));
    }
    seln::top16_of_64(v);
    float a[16], b[16];
#pragma unroll
    for (int i = 0; i < 16; ++i) { const auto rr = __builtin_amdgcn_permlane32_swap(__float_as_uint(v[0][i]), __float_as_uint(v[0][i]), false, false); a[i] = __uint_as_float(rr[0]); b[i] = __uint_as_float(rr[1]); }
    seln::merge16(a, b);
#pragma unroll
    for (int i = 0; i < 16; ++i) L[i] = a[i];
}
__device__ __forceinline__ void select_phase(const Frame& F, const bf16* pq, const bf16* sk, int* idxo, float* gateo) {
    const int lane = F.lane, r32 = lane & 31, hi = lane >> 5;
    LAS unsigned char* myl = F.lds + RING_OFF + (F.wave * 64 + lane) * 32;
    for (int it = F.gw; it < (T / 32) * 8; it += F.NGW) {
        const int tb = it >> 3, h = it & 7, t = tb * 32 + r32;
        float L0[16], L1[16];
        select_half(L0, pq + (size_t)t * PQD + h * 256 + hi * 8, sk + (size_t)((h * 2 + 0) * 128 + r32) * 128 + hi * 8, hi);
        select_half(L1, pq + (size_t)t * PQD + h * 256 + 128 + hi * 8, sk + (size_t)((h * 2 + 1) * 128 + r32) * 128 + hi * 8, hi);
        float c[4][16];
    c[0][0] = pk8(L0[0] + L1[0], 0x00u);
    c[0][1] = pk8(L0[0] + L1[1], 0x01u);
    c[0][2] = pk8(L0[0] + L1[2], 0x02u);
    c[0][3] = pk8(L0[0] + L1[3], 0x03u);
    c[0][4] = pk8(L0[0] + L1[4], 0x04u);
    c[0][5] = pk8(L0[0] + L1[5], 0x05u);
    c[0][6] = pk8(L0[0] + L1[6], 0x06u);
    c[0][7] = pk8(L0[0] + L1[7], 0x07u);
    c[0][8] = pk8(L0[0] + L1[8], 0x08u);
    c[0][9] = pk8(L0[0] + L1[9], 0x09u);
    c[0][10] = pk8(L0[0] + L1[10], 0x0au);
    c[0][11] = pk8(L0[0] + L1[11], 0x0bu);
    c[0][12] = pk8(L0[0] + L1[12], 0x0cu);
    c[0][13] = pk8(L0[0] + L1[13], 0x0du);
    c[0][14] = pk8(L0[0] + L1[14], 0x0eu);
    c[0][15] = pk8(L0[0] + L1[15], 0x0fu);
    c[1][0] = pk8(L0[1] + L1[0], 0x10u);
    c[1][1] = pk8(L0[1] + L1[1], 0x11u);
    c[1][2] = pk8(L0[1] + L1[2], 0x12u);
    c[1][3] = pk8(L0[1] + L1[3], 0x13u);
    c[1][4] = pk8(L0[1] + L1[4], 0x14u);
    c[1][5] = pk8(L0[1] + L1[5], 0x15u);
    c[1][6] = pk8(L0[1] + L1[6], 0x16u);
    c[1][7] = pk8(L0[1] + L1[7], 0x17u);
    c[1][8] = pk8(L0[2] + L1[0], 0x20u);
    c[1][9] = pk8(L0[2] + L1[1], 0x21u);
    c[1][10] = pk8(L0[2] + L1[2], 0x22u);
    c[1][11] = pk8(L0[2] + L1[3], 0x23u);
    c[1][12] = pk8(L0[2] + L1[4], 0x24u);
    c[1][13] = pk8(L0[3] + L1[0], 0x30u);
    c[1][14] = pk8(L0[3] + L1[1], 0x31u);
    c[1][15] = pk8(L0[3] + L1[2], 0x32u);
    c[2][0] = pk8(L0[3] + L1[3], 0x33u);
    c[2][1] = pk8(L0[4] + L1[0], 0x40u);
    c[2][2] = pk8(L0[4] + L1[1], 0x41u);
    c[2][3] = pk8(L0[4] + L1[2], 0x42u);
    c[2][4] = pk8(L0[5] + L1[0], 0x50u);
    c[2][5] = pk8(L0[5] + L1[1], 0x51u);
    c[2][6] = pk8(L0[6] + L1[0], 0x60u);
    c[2][7] = pk8(L0[6] + L1[1], 0x61u);
    c[2][8] = pk8(L0[7] + L1[0], 0x70u);
    c[2][9] = pk8(L0[7] + L1[1], 0x71u);
    c[2][10] = pk8(L0[8] + L1[0], 0x80u);
    c[2][11] = pk8(L0[9] + L1[0], 0x90u);
    c[2][12] = pk8(L0[10] + L1[0], 0xa0u);
    c[2][13] = pk8(L0[11] + L1[0], 0xb0u);
    c[2][14] = pk8(L0[12] + L1[0], 0xc0u);
    c[2][15] = pk8(L0[13] + L1[0], 0xd0u);
    c[3][0] = pk8(L0[14] + L1[0], 0xe0u);
    c[3][1] = pk8(L0[15] + L1[0], 0xf0u);
    c[3][2] = -3.0e38f;
    c[3][3] = -3.0e38f;
    c[3][4] = -3.0e38f;
    c[3][5] = -3.0e38f;
    c[3][6] = -3.0e38f;
    c[3][7] = -3.0e38f;
    c[3][8] = -3.0e38f;
    c[3][9] = -3.0e38f;
    c[3][10] = -3.0e38f;
    c[3][11] = -3.0e38f;
    c[3][12] = -3.0e38f;
    c[3][13] = -3.0e38f;
    c[3][14] = -3.0e38f;
    c[3][15] = -3.0e38f;
        seln::top16_of_64(c);
        v4u w0, w1, w2, w3;
#define B4(L, i) ((__float_as_uint(L[i]) & 0x7Fu) | ((__float_as_uint(L[i + 1]) & 0x7Fu) << 8) | ((__float_as_uint(L[i + 2]) & 0x7Fu) << 16) | ((__float_as_uint(L[i + 3]) & 0x7Fu) << 24))
        w0.x = B4(L0, 0); w0.y = B4(L0, 4); w0.z = B4(L0, 8); w0.w = B4(L0, 12); w1.x = B4(L1, 0); w1.y = B4(L1, 4); w1.z = B4(L1, 8); w1.w = B4(L1, 12);
#undef B4
        *(LAS v4u*)myl = w0; *(LAS v4u*)(myl + 16) = w1;
        LDS_WAIT();
        int e[16]; float gt[16]; float sum = 0.f; const float mx = c[0][0];
#pragma unroll
        for (int k = 0; k < 16; ++k) { const unsigned code = __float_as_uint(c[0][k]) & 0xFFu; const int n1 = myl[code >> 4], n2 = myl[16 + (code & 15u)];
            e[k] = n1 * 128 + n2; gt[k] = __expf(__uint_as_float(__float_as_uint(c[0][k]) & ~0xFFu) - mx); sum += gt[k]; }
        const float rs = 1.0f / sum;
        v4i eo0, eo1; f32x4 go0, go1;
        eo0.x = hi ? e[8] : e[0]; eo0.y = hi ? e[9] : e[1]; eo0.z = hi ? e[10] : e[2]; eo0.w = hi ? e[11] : e[3];
        eo1.x = hi ? e[12] : e[4]; eo1.y = hi ? e[13] : e[5]; eo1.z = hi ? e[14] : e[6]; eo1.w = hi ? e[15] : e[7];
        go0.x = (hi ? gt[8] : gt[0]) * rs; go0.y = (hi ? gt[9] : gt[1]) * rs; go0.z = (hi ? gt[10] : gt[2]) * rs; go0.w = (hi ? gt[11] : gt[3]) * rs;
        go1.x = (hi ? gt[12] : gt[4]) * rs; go1.y = (hi ? gt[13] : gt[5]) * rs; go1.z = (hi ? gt[14] : gt[6]) * rs; go1.w = (hi ? gt[15] : gt[7]) * rs;
        const size_t ob = (size_t)t * SLOTS + h * 16 + hi * 8;
        *(GAS v4i*)(idxo + ob) = eo0; *(GAS v4i*)(idxo + ob + 4) = eo1; *(GAS f32x4*)(gateo + ob) = go0; *(GAS f32x4*)(gateo + ob + 4) = go1;
        LDS_WAIT();
    }
}

struct XInfo { int pj, nx, rank, nloc; };
constexpr int NSUB = 2, PCOLS = 512 / NSUB, NPART = 8 * NSUB, NPART_U = 8;
#define dpp_f(v, CTRL) __uint_as_float((unsigned)__builtin_amdgcn_update_dpp(0, (int)__float_as_uint(v), CTRL, 0xF, 0xF, true))
__device__ __forceinline__ void experts_u_phase(const Frame& F, const XInfo X, const unsigned char* xh, const unsigned char* xl, const int* idx, const unsigned char* U, float* part) {
    const int lane = F.lane, n = lane & 15, kq = lane >> 4, ci = lane & 3, sj = (lane >> 2) & 3;
    LAS int* le = (LAS int*)(F.lds + RING_OFF + F.wave * 1024);
    const int lw = 32 * (lane & 3) + (lane >> 2);
    const int tstride = X.nloc * NWAVES, tfirst = X.rank * NWAVES + F.wave;
    if (tfirst >= T) return;
    const int tlast = tfirst + ((T - 1 - tfirst) / tstride) * tstride;
#define UBASE(e) (((unsigned)(e) << 8) + (unsigned)coff)
#define ULOADB(b) (*(const GAS v4u*)(tab + (b)))
    for (int s = X.pj; s < 8; s += X.nx) {
        const unsigned char* tab = U; const int cbase = s * 512, coff = s * (NEXP * 256) + (ci + 4 * kq) * 16;
        const unsigned char* xcol = xh + cbase + ((n & 3) + 4 * (kq >> 1)) * 32 + 16 * (kq & 1); (void)xl;
        int par = 0, t = tfirst, tn = t < tlast ? t + tstride : t;
        le[lw] = idx[(size_t)t * SLOTS + lane]; le[lw + 16] = idx[(size_t)t * SLOTS + 64 + lane];
        v4u xc0, xc1; { const GAS v4u* xp = (const GAS v4u*)(xcol + (size_t)t * DM); xc0 = xp[0]; xc1 = xp[16]; }
        int in0 = idx[(size_t)tn * SLOTS + lane], in1 = idx[(size_t)tn * SLOTS + 64 + lane];
        LDS_WAIT();
        v4u R[32];
#pragma unroll
        for (int g = 0; g < 32; ++g) R[g] = ULOADB(UBASE(le[32 * sj + g]));
        for (;;) {
            const int t2 = tn < tlast ? tn + tstride : tn;
            le[128 * (par ^ 1) + lw] = in0; le[128 * (par ^ 1) + lw + 16] = in1;
            const int j0 = idx[(size_t)t2 * SLOTS + lane], j1 = idx[(size_t)t2 * SLOTS + 64 + lane];
            att::v8i_t xb;
            { const unsigned wv[8] = {xc0.x, xc0.y, xc0.z, xc0.w, xc1.x, xc1.y, xc1.z, xc1.w};
#pragma unroll
              for (int q = 0; q < 8; ++q) xb[q] = (n < 4) ? (int)wv[q] : 0; }
            { const GAS v4u* xp = (const GAS v4u*)(xcol + (size_t)tn * DM); xc0 = xp[0]; xc1 = xp[16]; }
            float res[8] = {0.f, 0.f, 0.f, 0.f, 0.f, 0.f, 0.f, 0.f};
#define UM(G, D) do { v4i a = __builtin_bit_cast(v4i, R[(G)]); asm volatile("" : "+v"(a)); \
                D = __builtin_amdgcn_mfma_scale_f32_16x16x128_f8f6f4(__builtin_shufflevector(a, a, 0, 1, 2, 3, -1, -1, -1, -1), xb, (f32x4){0.f, 0.f, 0.f, 0.f}, 4, 0, 0, 0, 0, 0); } while (0)
#define UV(G, D) do { asm volatile("" : "+v"(D)); float s1_, s2_, v; \
                if (((G) & 1) == 0) { s1_ = D.x + dpp_f(D.y, 0xF5); s2_ = D.z + dpp_f(D.w, 0xF5); }     \
                else                { s1_ = D.y + dpp_f(D.x, 0xA0); s2_ = D.w + dpp_f(D.z, 0xA0); }     \
                if (((G) & 3) == 0) v = s1_ + dpp_f(s2_, 0xAA); else if (((G) & 3) == 2) v = s2_ + dpp_f(s1_, 0x00); else if (((G) & 3) == 1) v = s1_ + dpp_f(s2_, 0xFF); else v = s2_ + dpp_f(s1_, 0x55); \
                res[(G) >> 2] = (n == ((G) & 3)) ? v : res[(G) >> 2]; asm volatile("" : "+v"(res[(G) >> 2])); } while (0)
            LDS_WAIT();
            f32x4 Da, Db;
            __builtin_amdgcn_sched_barrier(0);
#pragma unroll
            for (int g4 = 0; g4 < 8; ++g4) {
                const v4i idv = *(const LAS v4i*)(le + 128 * (par ^ 1) + 32 * sj + 4 * g4);
                UM(4 * g4, Da); R[4 * g4] = ULOADB(UBASE(idv.x)); __builtin_amdgcn_sched_barrier(0); if (g4 > 0) UV(4 * g4 - 1, Db); __builtin_amdgcn_sched_barrier(0);
                UM(4 * g4 + 1, Db); R[4 * g4 + 1] = ULOADB(UBASE(idv.y)); __builtin_amdgcn_sched_barrier(0); UV(4 * g4, Da); __builtin_amdgcn_sched_barrier(0);
                UM(4 * g4 + 2, Da); R[4 * g4 + 2] = ULOADB(UBASE(idv.z)); __builtin_amdgcn_sched_barrier(0); UV(4 * g4 + 1, Db); __builtin_amdgcn_sched_barrier(0);
                UM(4 * g4 + 3, Db); R[4 * g4 + 3] = ULOADB(UBASE(idv.w)); __builtin_amdgcn_sched_barrier(0); UV(4 * g4 + 2, Da); __builtin_amdgcn_sched_barrier(0); }
            UV(31, Db);
#undef UM
#undef UV
            if (n < 4) { typedef _Float16 h2 __attribute__((ext_vector_type(2)));
                v4u pk;
                { const h2 a = {(_Float16)(res[0] * 0.0625f), (_Float16)(res[1] * 0.0625f)}, b = {(_Float16)(res[2] * 0.0625f), (_Float16)(res[3] * 0.0625f)}, c = {(_Float16)(res[4] * 0.0625f), (_Float16)(res[5] * 0.0625f)}, d = {(_Float16)(res[6] * 0.0625f), (_Float16)(res[7] * 0.0625f)};
                  pk.x = __builtin_bit_cast(unsigned, a); pk.y = __builtin_bit_cast(unsigned, b); pk.z = __builtin_bit_cast(unsigned, c); pk.w = __builtin_bit_cast(unsigned, d); }
                *(GAS v4u*)((_Float16*)part + ((size_t)t * NPART_U + s) * SLOTS + (4 * n + kq) * 8) = pk; }
            if (t == tlast) break;
            t = tn; tn = t2; par ^= 1; in0 = j0; in1 = j1;
        }
        LDS_WAIT();
    }
#undef UBASE
#undef ULOADB
}
__device__ __forceinline__ void glds16_off(unsigned voff, const void* gbase, unsigned lds_dst) { unsigned keep;
    asm volatile("s_mov_b32 %0, m0\n\ts_mov_b32 m0, %2\n\ts_nop 0\n\tglobal_load_lds_dwordx4 %1, %3\n\ts_mov_b32 m0, %0" : "=&s"(keep) : "v"(voff), "s"(lds_dst), "s"(gbase) : "memory"); }
__device__ __forceinline__ void experts_w_phase(const Frame& F, const int* idx, const float* gate, const float* part, const float* isU, const float* isV, unsigned char* wh8, unsigned char* wl8, float* wsi) {
    for (int t = F.gw; t < T; t += F.NGW) {
        float w[2];
#pragma unroll
        for (int q = 0; q < 2; ++q) { const int k = F.lane + 64 * q; const int e = idx[(size_t)t * SLOTS + k];
            float sum = 0.f;
#pragma unroll
            for (int j = 0; j < NPART_U; ++j) sum += (float)((const _Float16*)part)[((size_t)t * NPART_U + j) * SLOTS + ((k & 15) << 3) + (k >> 4)];
            sum *= isU[e];
            w[q] = gate[(size_t)t * SLOTS + k] * isV[e] * (0.5f * sum * (1.0f + erff(sum * 0.70710678118654752f))); }
        float mx = fmaxf(fabsf(w[0]), fabsf(w[1]));
#pragma unroll
        for (int o = 1; o < 64; o <<= 1) mx = fmaxf(mx, __shfl_xor(mx, o));
        const float sw = mx > 0.f ? 224.f / mx : 1.f;
#pragma unroll
        for (int q = 0; q < 2; ++q) { const float y = w[q] * sw;
            const int hb = __builtin_amdgcn_cvt_pk_fp8_f32(y, 0.f, 0, false) & 0xFF;
            wh8[(size_t)t * SLOTS + F.lane + 64 * q] = (unsigned char)hb; (void)wl8; }
        if (F.lane == 0) wsi[t] = mx > 0.f ? mx * (1.f / 224.f) : 1.f;
    }
}
template <bool FINAL>
__device__ __forceinline__ void experts_v_phase(const Frame& F, const XInfo X, const int* idx, const unsigned char* wh8, const unsigned char* wl8, const float* wsi, const unsigned char* V, bf16* h, float* hout) {
    const int lane = F.lane, n = lane & 15, kq = lane >> 4;
    constexpr int VSLOT = 1040;
    LAS unsigned char* ringp = F.lds + RING_OFF + F.wave * (16 * VSLOT);
    LAS int* le2 = (LAS int*)(F.lds + VL_OFF + F.wave * VL_WAVE);
    LAS float* stage = (LAS float*)ringp;
    const unsigned ring_addr = (unsigned)(__SIZE_TYPE__)ringp;
    const int trb = (int)ring_addr + (2 * (kq & 1) + ((n >> 1) & 1)) * VSLOT + 64 * (n >> 2) + 16 * (kq >> 1) + 8 * (n & 1);
    const int lp = 32 * ((lane >> 1) & 3) + 8 * (lane >> 5) + 4 * ((lane >> 3) & 1) + 2 * ((lane >> 4) & 1) + (lane & 1);
    const unsigned selE = (n & 1) ? 0x010c000cu : 0x0c010c00u, selO = (n & 1) ? 0x030c020cu : 0x0c030c02u;
    const unsigned mlo = (n < 2) ? 0xFFFFFFFFu : 0u, mhi = (n >= 2 && n < 4) ? 0xFFFFFFFFu : 0u;
    for (int s = X.pj; s < 8; s += X.nx) {
        const int cbase = s * 512; const unsigned coff = (unsigned)(s * (NEXP * 256) + 64 * kq + 16 * (lane & 3));
        const int tfirst = X.rank * NWAVES + F.wave, tstep = X.nloc * NWAVES;
        if (tfirst >= T) continue;
        int pid0 = idx[(size_t)tfirst * SLOTS + lane], pid1 = idx[(size_t)tfirst * SLOTS + 64 + lane];
        v2u pBw[4]; float prsw = wsi[tfirst];
        { const unsigned char* wsrc = wh8 + (size_t)tfirst * SLOTS + 8 * kq; (void)wl8;
#pragma unroll
          for (int sb = 0; sb < 4; ++sb) pBw[sb] = *(const GAS v2u*)(wsrc + 32 * sb); }
        for (int t = tfirst; t < T; t += tstep) {
            le2[lp] = pid0; le2[lp + 16] = pid1;
            v2u Bw[4];
#pragma unroll
            for (int sb = 0; sb < 4; ++sb) Bw[sb] = pBw[sb];
            const float rsw = prsw;
            { const int tn = t + tstep < T ? t + tstep : t;
              pid0 = idx[(size_t)tn * SLOTS + lane]; pid1 = idx[(size_t)tn * SLOTS + 64 + lane]; prsw = wsi[tn];
              const unsigned char* wsrc = wh8 + (size_t)tn * SLOTS + 8 * kq;
#pragma unroll
              for (int sb = 0; sb < 4; ++sb) pBw[sb] = *(const GAS v2u*)(wsrc + 32 * sb); }
            LDS_WAIT();
            unsigned base[32];
#pragma unroll
            for (int L = 0; L < 32; ++L) base[L] = ((unsigned)le2[32 * ((lane >> 2) & 3) + L] << 8) + coff;
            f32x4 D[8]; v2u hold[2];
#pragma unroll
            for (int j = 0; j < 8; ++j) D[j] = (f32x4){0.f, 0.f, 0.f, 0.f};
#define VDMA(L) glds16_off(base[L], V, ring_addr + ((L) & 15) * VSLOT)
            asm volatile("" ::: "memory");
#pragma unroll
            for (int L = 0; L < 16; ++L) VDMA(L);
#pragma unroll
            for (int sb = 0; sb < 4; ++sb) {
                if (sb < 2) asm volatile("s_waitcnt vmcnt(8)" ::: "memory"); else if (sb == 2) asm volatile("s_waitcnt vmcnt(10)" ::: "memory");   else asm volatile("s_waitcnt vmcnt(0)" ::: "memory");
                v2i a0[8], a1[8];
#pragma unroll
                for (int j = 0; j < 8; ++j) {
                    asm volatile("ds_read_b64_tr_b8 %0, %1 offset:%2" : "=&v"(a0[j]) : "v"(trb), "i"(((sb & 1) * 8) * VSLOT + 256 * (j >> 1) + 32 * (j & 1)) : "memory");
                    asm volatile("ds_read_b64_tr_b8 %0, %1 offset:%2" : "=&v"(a1[j]) : "v"(trb), "i"(((sb & 1) * 8 + 4) * VSLOT + 256 * (j >> 1) + 32 * (j & 1)) : "memory"); }
                asm volatile("s_waitcnt lgkmcnt(0)" ::: "memory"); __builtin_amdgcn_sched_barrier(0);
                if (sb < 2) {
#pragma unroll
                    for (int L8 = 0; L8 < 8; ++L8) VDMA(16 + 8 * sb + L8);
                }
                if (sb == 1) { hold[0] = *(const GAS v2u*)(h + (size_t)t * DM + cbase + 4 * lane); hold[1] = *(const GAS v2u*)(h + (size_t)t * DM + cbase + 256 + 4 * lane); asm volatile("" ::: "memory"); }
                att::v8i_t B;
                { const unsigned e0 = __builtin_amdgcn_perm(0u, Bw[sb].x, selE), e1 = __builtin_amdgcn_perm(0u, Bw[sb].x, selO), e2 = __builtin_amdgcn_perm(0u, Bw[sb].y, selE), e3 = __builtin_amdgcn_perm(0u, Bw[sb].y, selO);
                  B[0] = (int)(e0 & mlo); B[1] = (int)(e1 & mlo); B[2] = (int)(e2 & mlo); B[3] = (int)(e3 & mlo); B[4] = (int)(e0 & mhi); B[5] = (int)(e1 & mhi); B[6] = (int)(e2 & mhi); B[7] = (int)(e3 & mhi); }
#pragma unroll
                for (int j = 0; j < 8; ++j) { const att::v8i_t A = {a0[j].x, a0[j].y, a1[j].x, a1[j].y, 0, 0, 0, 0};
                    D[j] = __builtin_amdgcn_mfma_scale_f32_16x16x128_f8f6f4(A, B, D[j], 4, 0, 0, 0, 0, 0); }
                __builtin_amdgcn_sched_barrier(0);
            }
#undef VDMA
            if (n < 4) {
#pragma unroll
                for (int j = 0; j < 8; ++j) *(LAS f32x4*)(stage + 32 * (2 * j + (n >> 1)) + 16 * (n & 1) + 4 * kq) = D[j];
            }
            LDS_WAIT();
#pragma unroll
            for (int q = 0; q < 2; ++q) { const f32x4 hi4 = *(const LAS f32x4*)(stage + 256 * q + 4 * lane);
              f32x4 o = (f32x4){bflo(hold[q].x), bfhi(hold[q].x), bflo(hold[q].y), bfhi(hold[q].y)};
              o.x += hi4.x * rsw; o.y += hi4.y * rsw; o.z += hi4.z * rsw; o.w += hi4.w * rsw;
              if constexpr (FINAL) *(GAS f32x4*)(hout + (size_t)t * DM + cbase + 256 * q + 4 * lane) = o;
              else { v2u ob; ob.x = pk2(o.x, o.y); ob.y = pk2(o.z, o.w); *(GAS v2u*)(h + (size_t)t * DM + cbase + 256 * q + 4 * lane) = ob; } }
            LDS_WAIT();
        }
    }
}

__device__ __forceinline__ void load_u8(float (&u)[8], const bf16* p) {
    const v4u c = *(const GAS v4u*)p;
    u[0] = bflo(c.x); u[1] = bfhi(c.x); u[2] = bflo(c.y); u[3] = bfhi(c.y); u[4] = bflo(c.z); u[5] = bfhi(c.z); u[6] = bflo(c.w); u[7] = bfhi(c.w);
}
__device__ __forceinline__ void conv_phase(const Frame& F, const bf16* bg, const bf16* ub, const float* cw, const float* cb, bf16* y) {
    for (int it = F.gw; it < (T / 32) * 8; it += F.NGW) {
        const int run = it >> 3, ch = (it & 7) * 512 + F.lane * 8, t0 = run * 32;
        float w0[8], w1[8], w2[8], bb[8];
#pragma unroll
        for (int i = 0; i < 8; ++i) { w0[i] = cw[ch + i]; w1[i] = cw[DM + ch + i]; w2[i] = cw[2 * DM + ch + i]; bb[i] = cb[ch + i]; }
        float up[8], uc[8], un[8];
        if ((t0 & (SEQ - 1)) == 0) {
#pragma unroll
            for (int i = 0; i < 8; ++i) up[i] = 0.f;
        } else load_u8(up, ub + (size_t)(t0 - 1) * DM + ch);
        load_u8(uc, ub + (size_t)t0 * DM + ch);
        for (int i0 = 0; i0 < 32; i0 += 8) {
            v4u ur[8], br[8];
#pragma unroll
            for (int q = 0; q < 8; ++q) { const int t = t0 + i0 + q; const bool last = (t & (SEQ - 1)) == SEQ - 1;
                ur[q] = *(const GAS v4u*)(ub + (size_t)(last ? t : t + 1) * DM + ch); if (last) ur[q] = (v4u){0u, 0u, 0u, 0u};
                br[q] = *(const GAS v4u*)(bg + (size_t)t * DM + ch); }
#pragma unroll
            for (int q = 0; q < 8; ++q) { const int t = t0 + i0 + q;
                un[0] = bflo(ur[q].x); un[1] = bfhi(ur[q].x); un[2] = bflo(ur[q].y); un[3] = bfhi(ur[q].y); un[4] = bflo(ur[q].z); un[5] = bfhi(ur[q].z); un[6] = bflo(ur[q].w); un[7] = bfhi(ur[q].w);
                const float bgv[8] = {bflo(br[q].x), bfhi(br[q].x), bflo(br[q].y), bfhi(br[q].y), bflo(br[q].z), bfhi(br[q].z), bflo(br[q].w), bfhi(br[q].w)};
                float o[8];
#pragma unroll
                for (int c = 0; c < 8; ++c) { const float cv = up[c] * w0[c] + uc[c] * w1[c] + un[c] * w2[c] + bb[c]; o[c] = bgv[c] * cv; up[c] = uc[c]; uc[c] = un[c]; }
                v4u w; w.x = pk2(o[0], o[1]); w.y = pk2(o[2], o[3]); w.z = pk2(o[4], o[5]); w.w = pk2(o[6], o[7]);
                *(GAS v4u*)(y + (size_t)t * DM + ch) = w; }
        }
    }
}

constexpr int NPHASE = 17;
struct Args { const float* in[15]; float* out; unsigned char* ws; int ph_lo, ph_hi; };
static_assert(sizeof(Args) == 15 * 8 + 8 + 8 + 8, "Args has no padding");
__global__ void __launch_bounds__(NWAVES * 64, 2) mk_fwd(Args args) {
    extern __shared__ __attribute__((aligned(16))) unsigned char lds_raw[];
    Frame F;
    F.lds = (LAS unsigned char*)lds_raw;
    F.tid = threadIdx.x; F.lane = F.tid & 63; F.wave = __builtin_amdgcn_readfirstlane(F.tid >> 6);
    F.G = gridDim.x; { const int bx = blockIdx.x; F.vcu = (F.G % 8 == 0) ? (bx % 8) * (F.G / 8) + bx / 8 : bx; }
    F.gw = F.vcu * NWAVES + F.wave; F.NGW = F.G * NWAVES;
    unsigned char* ws = args.ws;
    gu32* ctl = (gu32*)(ws + WS_CTL);
    volatile LAS unsigned* MISC = (volatile LAS unsigned*)(F.lds + MISC_OFF);
    for (int u = F.tid; u < (LDS_BYTES - MISC_OFF) / 4; u += NWAVES * 64) ((LAS unsigned*)(F.lds + MISC_OFF))[u] = 0u;
    __syncthreads();
    XcdBarrier bar; bar.bar = (unsigned*)(ctl + CW_BAR); bar.x = 0; bar.st = nullptr;
    const int lo = args.ph_lo, hi = args.ph_hi;
    if (hi - lo > 1) bar = xcd_barrier_post((unsigned*)(ctl + CW_BAR), MISC + 8);
    const int xid = (int)xb_xcc_id();
    if (F.tid == 0) MISC[16] = __hip_atomic_fetch_add(ctl + CW_RANK + 64 * xid, 1u, RLX_AGENT);
    __syncthreads();
    XInfo X; X.rank = __builtin_amdgcn_readfirstlane((int)MISC[16]); X.pj = 0; X.nx = 1; X.nloc = 1;
#ifndef MK_ONLY
#define MK_ONLY -1
#endif
#define IN(k) ((MK_ONLY < 0 || MK_ONLY == (k)) && lo <= (k) && (k) < hi)
#define SEAM(k) do { if (IN(k) && IN((k) + 1)) xcd_barrier(bar); } while (0)
    const float* x = args.in[0]; const float* mixer_g = args.in[1]; const float* ffn_g = args.in[2];
    float* out = args.out;
    unsigned char* WQKV8 = ws + WS_WQKV; unsigned char* HN8 = ws + WS_HN; float* SCL = (float*)(ws + WS_ISC + 262144); unsigned char* WO8 = ws + WS_WO; unsigned char* O8 = ws + WS_O; unsigned char* QK8 = ws + WS_BCX; unsigned char* V8A = ws + WS_BCX + 80 * MiB;   bf16* Win_t = (bf16*)(ws + WS_WIN); bf16* Wout_t = (bf16*)(ws + WS_WOUT);
    bf16* Wpq_t = (bf16*)(ws + WS_WPQ); bf16* SK = (bf16*)(ws + WS_SK); float* ROPE = (float*)(ws + WS_ROPE); unsigned char* U8 = ws + WS_U;   unsigned char* X8H = ws + WS_O; unsigned char* X8L = ws + WS_O + 64 * MiB;   unsigned char* V8 = ws + WS_V; float* ISU = (float*)(ws + WS_ISC); float* ISV = ISU + 2 * NEXP;
    bf16* HN = (bf16*)(ws + WS_HN); bf16* QKV = (bf16*)(ws + WS_QKV); bf16* HB = (bf16*)(ws + WS_QKV); float* RS = (float*)(ws + WS_ROPE + 524288);     bf16* OB = (bf16*)(ws + WS_O); bf16* PQ = (bf16*)(ws + WS_PQ);
    float* PART = (float*)(ws + WS_PART); unsigned char* WH8 = ws + WS_WQ8; unsigned char* WL8 = WH8 + (size_t)T * SLOTS; float* WSI = (float*)(WL8 + (size_t)T * SLOTS); int* IDX = (int*)(ws + WS_IDX); float* GATE = (float*)(ws + WS_GATE); bf16* BCX = (bf16*)(ws + WS_BCX); bf16* YB = (bf16*)(ws + WS_Y);
    PG8_LAS unsigned char* ring = (PG8_LAS unsigned char*)(F.lds + RING_OFF);

    if (IN(0)) {
        amax_tensor(F, args.in[3], (size_t)DM * QKVD / 4, ctl + CW_AMAX);
        amax_tensor(F, args.in[4], (size_t)DM * DM / 4, ctl + CW_AMAX + 64);
        xcd_barrier(bar);
        const f32x2 sq = pow2_scale(__hip_atomic_load(ctl + CW_AMAX, RLX_AGENT)), so = pow2_scale(__hip_atomic_load(ctl + CW_AMAX + 64, RLX_AGENT));
        if (blockIdx.x == 0 && F.tid == 0) { SCL[0] = sq.y; SCL[1] = so.y; }
        transpose_all<false, true>(F, args.in[3], DM, QKVD, WQKV8, sq.x);
        transpose_all<false, true>(F, args.in[4], DM, DM, WO8, so.x);
        transpose_all<true, false>(F, args.in[7], DM, CIN, Win_t, 1.f, mixer_g + DM);
        transpose_all(F, args.in[10], DM, DM, Wout_t);
        transpose_all(F, args.in[11], DM, PQD, Wpq_t, 1.f, ffn_g);
        transpose_all(F, args.in[11] + (size_t)DM * PQD, DM, PQD, Wpq_t + (size_t)PQD * DM, 1.f, ffn_g + DM);
        cvt_copy(F, args.in[12], SK, (size_t)2 * 16 * 128 * 128 / 8);
        cvt_rows_fp4<false>(F, args.in[13], U8, ISU, 2 * NEXP);
        cvt_rows_fp4<true>(F, args.in[14], V8, ISV, 2 * NEXP);
        if (F.vcu == 0) rope_table(F, ROPE);
        for (int m = F.gw; m < T; m += F.NGW) rms_row_to_fp8(x + (size_t)m * DM, mixer_g, HN8 + (size_t)m * DM, F.lane);
    }
    SEAM(0);
    { int nx = 0, pj = 0, nloc = 1;
#pragma unroll
      for (int j = 0; j < 16; ++j) { const int cj = (int)__hip_atomic_load(ctl + CW_RANK + 64 * j, RLX_AGENT); nx += cj > 0; pj += (cj > 0 && j < xid); nloc = (j == xid) ? cj : nloc; }
      X.nx = __builtin_amdgcn_readfirstlane(nx > 0 ? nx : 1); X.pj = __builtin_amdgcn_readfirstlane(pj); X.nloc = __builtin_amdgcn_readfirstlane(nloc > 0 ? nloc : 1); }
    if (IN(1)) { pg8::Gemm g{(const bf16*)HN8, (const bf16*)WQKV8, T, QKVD, DM / 2}; pg8::StaticOrder S; S.init(T, QKVD, F.G, (int)blockIdx.x);
        pg8::EpiBf16S E{QKV, QKVD, SCL, 0.0625f, (unsigned*)(ctl + CW_AMAX + 128), 5120};
        pg8::gemm_phase<pg8::EpiBf16S, pg8::StaticOrder, true, true, true>(ring, g, S, E); }
    SEAM(1);
    if (IN(2)) qknorm_rope_phase(F, QKV, QK8, V8A, args.in[5], args.in[6], ROPE, ctl + CW_AMAX + 128);
    SEAM(2);
    if (IN(3)) { const f32x2 sv = pow2_scale(__hip_atomic_load(ctl + CW_AMAX + 128, RLX_AGENT)); if (blockIdx.x == 0 && F.tid == 0) SCL[2] = sv.y;
        attention_phase(F, QK8, V8A, O8, (char*)lds_raw + RING_OFF); }
    SEAM(3);
    if (IN(4)) { pg8::Gemm g{(const bf16*)O8, (const bf16*)WO8, T, DM, DM / 2}; pg8::StaticOrder S; S.init(T, DM, F.G, (int)blockIdx.x);
        pg8::EpiBf16ResS E{HB, x, DM, SCL + 1, SCL + 2};
        pg8::gemm_phase<pg8::EpiBf16ResS, pg8::StaticOrder, true, true, true>(ring, g, S, E); }
    SEAM(4);
    if (IN(5)) norm_phase_b<true>(F, HB, ffn_g, RS, X8H);
    SEAM(5);
    if (IN(6)) { pg8::Gemm g{HB, Wpq_t, T, PQD, DM}; pg8::StaticOrder S; S.init(T, PQD, F.G, (int)blockIdx.x);
        pg8::EpiBf16Row E{PQ, PQD, RS};
        pg8::gemm_phase<pg8::EpiBf16Row, pg8::StaticOrder, true, true>(ring, g, S, E); }
    SEAM(6);
    if (IN(7)) select_phase(F, PQ, SK, IDX, GATE);
    SEAM(7);
    if (IN(8)) { experts_u_phase(F, X, X8H, X8L, IDX, U8, PART); xcd_barrier(bar); experts_w_phase(F, IDX, GATE, PART, ISU, ISV, WH8, WL8, WSI); xcd_barrier(bar); experts_v_phase<false>(F, X, IDX, WH8, WL8, WSI, V8, HB, out); }
    SEAM(8);
    if (IN(9)) norm_phase_b<false>(F, HB, mixer_g + DM, RS, nullptr);
    SEAM(9);
    if (IN(10)) { pg8::Gemm g{HB, Win_t, T, CIN, DM}; pg8::StaticOrder S; S.init(T, CIN, F.G, (int)blockIdx.x);
        pg8::EpiConvIn E{BCX, BCX + (size_t)T * DM, DM, RS};
        pg8::gemm_phase<pg8::EpiConvIn, pg8::StaticOrder, true, true>(ring, g, S, E); }
    SEAM(10);
    if (IN(11)) conv_phase(F, BCX, BCX + (size_t)T * DM, args.in[8], args.in[9], YB);
    SEAM(11);
    if (IN(12)) { pg8::Gemm g{YB, Wout_t, T, DM, DM}; pg8::StaticOrder S; S.init(T, DM, F.G, (int)blockIdx.x);
        pg8::EpiBf16Res E{HB, DM};
        pg8::gemm_phase<pg8::EpiBf16Res, pg8::StaticOrder, true, true>(ring, g, S, E); }
    SEAM(12);
    if (IN(13)) norm_phase_b<true>(F, HB, ffn_g + DM, RS, X8H);
    SEAM(13);
    if (IN(14)) { pg8::Gemm g{HB, Wpq_t + (size_t)PQD * DM, T, PQD, DM}; pg8::StaticOrder S; S.init(T, PQD, F.G, (int)blockIdx.x);
        pg8::EpiBf16Row E{PQ, PQD, RS};
        pg8::gemm_phase<pg8::EpiBf16Row, pg8::StaticOrder, true, true>(ring, g, S, E); }
    SEAM(14);
    if (IN(15)) select_phase(F, PQ, SK + (size_t)16 * 128 * 128, IDX, GATE);
    SEAM(15);
    if (IN(16)) { experts_u_phase(F, X, X8H, X8L, IDX, U8 + (size_t)NEXP * (DM / 2), PART); xcd_barrier(bar); experts_w_phase(F, IDX, GATE, PART, ISU + NEXP, ISV + NEXP, WH8, WL8, WSI); xcd_barrier(bar); experts_v_phase<true>(F, X, IDX, WH8, WL8, WSI, V8 + (size_t)NEXP * (DM / 2), HB, out); }
#undef IN
#undef SEAM
}

extern "C" void kernel_launch(void* const* d_in, const int* in_sizes, int n_in, void* d_out, int out_size, void* d_ws, size_t ws_size, hipStream_t stream) {
    static int grid = 0;
    if (grid == 0) {
        if (n_in != 15 || in_sizes[0] != T * DM || out_size != T * DM || ws_size < WS_END) { fprintf(stderr, "kernel_launch: shape mismatch (n_in %d, in0 %d, out %d, ws %zu < %zu); nothing launched\n", n_in, n_in > 0 ? in_sizes[0] : -1, out_size, ws_size, (size_t)WS_END); grid = -1; return; }
        int dev = 0, cus = 0, per_cu = 0;
        if (hipGetDevice(&dev) != hipSuccess || hipDeviceGetAttribute(&cus, hipDeviceAttributeMultiprocessorCount, dev) != hipSuccess) { grid = -1; return; }
        if (hipFuncSetAttribute((const void*)mk_fwd, hipFuncAttributeMaxDynamicSharedMemorySize, LDS_BYTES) != hipSuccess) { fprintf(stderr, "kernel_launch: hipFuncSetAttribute failed\n"); grid = -1; return; }
        if (hipOccupancyMaxActiveBlocksPerMultiprocessor(&per_cu, (const void*)mk_fwd, NWAVES * 64, LDS_BYTES) != hipSuccess || per_cu < 1) { fprintf(stderr, "kernel_launch: occupancy query reports %d workgroups per CU\n", per_cu); }
        (void)hipGetLastError();
        grid = cus;
    }
    if (grid < 0) return;
    if (hipMemsetAsync((char*)d_ws + WS_CTL, 0, CTL_ZERO_BYTES, stream) != hipSuccess) return;
    Args a{};
    for (int i = 0; i < 15; ++i) a.in[i] = (const float*)d_in[i];
    a.out = (float*)d_out; a.ws = (unsigned char*)d_ws;
#if MK_PER_PHASE
    for (int p = 0; p < NPHASE; ++p) { a.ph_lo = p; a.ph_hi = p + 1; hipLaunchKernelGGL(mk_fwd, dim3(grid), dim3(NWAVES * 64), LDS_BYTES, stream, a); }
#else
    a.ph_lo = 0; a.ph_hi = NPHASE; hipLaunchKernelGGL(mk_fwd, dim3(grid), dim3(NWAVES * 64), LDS_BYTES, stream, a);
#endif
    const hipError_t le = hipPeekAtLastError();
    if (le != hipSuccess) fprintf(stderr, "kernel_launch: launch failed: %s\n", hipGetErrorName(le));
}
```

```cpp
#include <hip/hip_runtime.h>
#include <cstdio>
#include <cstdint>
namespace pg8 {
#define PG8_LAS __attribute__((address_space(3)))
typedef unsigned short bf16_t;
typedef short bf16x8 __attribute__((ext_vector_type(8)));
typedef float f32x4 __attribute__((ext_vector_type(4)));
typedef unsigned u32x4 __attribute__((ext_vector_type(4)));
typedef int v4i_t __attribute__((ext_vector_type(4)));
typedef int v8i_t __attribute__((ext_vector_type(8)));
constexpr int BM = 256, BK = 64, HALF = 128, HTB = HALF * BK * 2  , STAGE_BYTES = 8 * HTB, NXCD = 8, WGM = 8;

__host__ __device__ __forceinline__ int lds_byte(int r, int c) { const int st = (r >> 4) * 2 + (c >> 5), rr = r & 15, cc = c & 31, ob = rr * 64 + cc * 2; return st * 1024 + (ob ^ (((ob >> 9) & 1) << 5)); }
__host__ __device__ __forceinline__ void stage_rc(int b, int& R, int& C) { const int st = b / 1024, sb = b % 1024, swz = sb ^ (((sb >> 9) & 1) << 5); R = (st >> 1) * 16 + swz / 64; C = (st & 1) * 32 + (swz % 64) / 2; }
__host__ __device__ __forceinline__ int perm32(int rho) { const int n = rho >> 4, i = rho & 15; return 8 * (i >> 2) + 4 * n + (i & 3); }

struct Unit { int pm, pn; };
struct Gemm { const bf16_t* A; const bf16_t* Bt; int M, N, K; };

struct StaticOrder {
    int nM, nN, nwg, G, c;
    __host__ __device__ void init(int M, int N, int G_, int c_) { nM = M / BM; nN = N / BM; nwg = nM * nN; G = G_; c = c_; }
    __host__ __device__ bool next(int i, Unit& u) const {
        const long L = (long)i * G + c; if (L >= nwg) return false;
        int wgid = (int)L; { const int q = nwg / NXCD, r = nwg % NXCD, xcd = wgid % NXCD, off = wgid / NXCD; wgid = (xcd < r ? xcd * (q + 1) : r * (q + 1) + (xcd - r) * q) + off; }
        const int nig = WGM * nN, gid = wgid / nig, fm = gid * WGM, gsz = (nM - fm) < WGM ? (nM - fm) : WGM;
        u.pm = fm + ((wgid % nig) % gsz); u.pn = (wgid % nig) / gsz; return true;
    }
    __device__ __forceinline__ void a_ready(const Unit&) const {}
    __device__ __forceinline__ void done(const Unit&) const {}
};
__device__ __forceinline__ unsigned cvt_pk_bf16(float lo, float hi) { unsigned r; asm volatile("v_cvt_pk_bf16_f32 %0, %1, %2" : "=v"(r) : "v"(lo), "v"(hi)); return r; }
typedef float f32x2 __attribute__((ext_vector_type(2)));
__device__ __forceinline__ f32x2 gelu_pk(f32x2 v) {
    const f32x2 av = __builtin_elementwise_abs(v), d = av * 0.2316418882f + 1.0f;
    f32x2 t; t.x = __builtin_amdgcn_rcpf(d.x); t.y = __builtin_amdgcn_rcpf(d.y);
    f32x2 q = t * 0.5307027145f + (-0.7265760135f); q = q * t + 0.7107068705f; q = q * t + (-0.142248368f); q = q * t + 0.127414796f; q = q * t;
    const f32x2 s = (v * v) * (-0.72134752044f);
    f32x2 e; e.x = __builtin_amdgcn_exp2f(s.x); e.y = __builtin_amdgcn_exp2f(s.y);
    const f32x2 m = v * (q * e), r = v - m;
    f32x2 o; o.x = v.x < 0.f ? m.x : r.x; o.y = v.y < 0.f ? m.y : r.y; return o;
}

template <int ACT  > struct EpiBf16 {
    static constexpr bool PERM = true, AFTER_DRAIN = false; static_assert(ACT == 0 || ACT == 1, "EpiBf16: ACT is 0 (none) or 1 (gelu_pk)");
    bf16_t* O; int ldc; const float* bias; int split_cols; size_t split_stride; float scale0;
    __device__ __forceinline__ void operator()(const f32x4 (&acc)[2][2][4][2], const Unit& u, int wr, int wc, int fr, int fq) const {
        const int row0 = u.pm * BM + wr * 64 + fr; int colt = u.pn * BM; bf16_t* base = O;
        float sc = 1.f; if (split_cols) { const int t = colt / split_cols; base += (size_t)t * split_stride; colt -= t * split_cols; if (t == 0) sc = scale0; }
        const int col0 = colt + wc * 32 + 8 * fq, bcol0 = u.pn * BM + wc * 32 + 8 * fq;
        f32x4 bv[2][2];
#pragma unroll
        for (int bj = 0; bj < 2; ++bj)
#pragma unroll
            for (int n = 0; n < 2; ++n) bv[bj][n] = bias ? *(const f32x4*)(bias + bcol0 + bj * HALF + 4 * n) : (f32x4){0.f, 0.f, 0.f, 0.f};
#pragma unroll
        for (int ai = 0; ai < 2; ++ai)
#pragma unroll
            for (int m = 0; m < 4; ++m) { bf16_t* rowp = base + (size_t)(row0 + ai * HALF + m * 16) * ldc + col0;
#pragma unroll
                for (int bj = 0; bj < 2; ++bj) { f32x4 v0 = acc[ai][bj][m][0] + bv[bj][0], v1 = acc[ai][bj][m][1] + bv[bj][1];
                    if (ACT == 1) { f32x2 a = gelu_pk((f32x2){v0[0], v0[1]}), b = gelu_pk((f32x2){v0[2], v0[3]}), c = gelu_pk((f32x2){v1[0], v1[1]}), d = gelu_pk((f32x2){v1[2], v1[3]});
                        v0 = (f32x4){a.x, a.y, b.x, b.y}; v1 = (f32x4){c.x, c.y, d.x, d.y}; }
                    v0 = v0 * sc; v1 = v1 * sc; u32x4 w; w.x = cvt_pk_bf16(v0[0], v0[1]); w.y = cvt_pk_bf16(v0[2], v0[3]); w.z = cvt_pk_bf16(v1[0], v1[1]); w.w = cvt_pk_bf16(v1[2], v1[3]);
                    *(u32x4*)(rowp + bj * HALF) = w; } }
    }
};
struct EpiF32Res {
    static constexpr bool PERM = false, AFTER_DRAIN = false;
    float* C; const float* R; int ldc;
    __device__ __forceinline__ void operator()(const f32x4 (&acc)[2][2][4][2], const Unit& u, int wr, int wc, int fr, int fq) const {
        const int row0 = u.pm * BM + wr * 64 + fr, col0 = u.pn * BM + wc * 32 + 4 * fq;
#pragma unroll
        for (int ai = 0; ai < 2; ++ai)
#pragma unroll
            for (int m = 0; m < 4; ++m) { const size_t off = (size_t)(row0 + ai * HALF + m * 16) * ldc + col0;
#pragma unroll
                for (int bj = 0; bj < 2; ++bj)
#pragma unroll
                    for (int n = 0; n < 2; ++n) { const f32x4 r = *(const f32x4*)(R + off + bj * HALF + n * 16); *(f32x4*)(C + off + bj * HALF + n * 16) = acc[ai][bj][m][n] + r; } }
    }
};
struct EpiConvIn {
    static constexpr bool PERM = true, AFTER_DRAIN = false;
    bf16_t* Bg; bf16_t* U; int ld; const float* rs;
    __device__ __forceinline__ void operator()(const f32x4 (&acc)[2][2][4][2], const Unit& u, int wr, int wc, int fr, int fq) const {
        const int row0 = u.pm * BM + wr * 64 + fr;
        if (u.pn < 16) {
            const int col0 = u.pn * BM + wc * 32 + 8 * fq;
#pragma unroll
            for (int ai = 0; ai < 2; ++ai)
#pragma unroll
                for (int m = 0; m < 4; ++m) { bf16_t* rowp = Bg + (size_t)(row0 + ai * HALF + m * 16) * ld + col0; const float r = rs[row0 + ai * HALF + m * 16];
#pragma unroll
                    for (int bj = 0; bj < 2; ++bj) { const f32x4 v0 = acc[ai][bj][m][0] * r, v1 = acc[ai][bj][m][1] * r;
                        u32x4 w; w.x = cvt_pk_bf16(v0[0], v0[1]); w.y = cvt_pk_bf16(v0[2], v0[3]); w.z = cvt_pk_bf16(v1[0], v1[1]); w.w = cvt_pk_bf16(v1[2], v1[3]);
                        *(u32x4*)(rowp + bj * HALF) = w; } }
        } else {
            const int col0 = (u.pn - 16) * HALF + wc * 32 + 8 * fq;
#pragma unroll
            for (int ai = 0; ai < 2; ++ai)
#pragma unroll
                for (int m = 0; m < 4; ++m) { const float r = rs[row0 + ai * HALF + m * 16], r2 = r * r; const f32x4 v0 = acc[ai][0][m][0] * acc[ai][1][m][0] * r2, v1 = acc[ai][0][m][1] * acc[ai][1][m][1] * r2;
                    u32x4 w; w.x = cvt_pk_bf16(v0[0], v0[1]); w.y = cvt_pk_bf16(v0[2], v0[3]); w.z = cvt_pk_bf16(v1[0], v1[1]); w.w = cvt_pk_bf16(v1[2], v1[3]);
                    *(u32x4*)(U + (size_t)(row0 + ai * HALF + m * 16) * ld + col0) = w; }
        }
    }
};
struct EpiBf16S {
    static constexpr bool PERM = true, AFTER_DRAIN = false;
    bf16_t* O; int ldc; const float* scp; float mul; unsigned* amax_word; int amax_col0;
    __device__ __forceinline__ void operator()(const f32x4 (&acc)[2][2][4][2], const Unit& u, int wr, int wc, int fr, int fq) const {
        const int row0 = u.pm * BM + wr * 64 + fr, col0 = u.pn * BM + wc * 32 + 8 * fq; const float sc = *scp * mul; float mx = 0.f;
#pragma unroll
        for (int ai = 0; ai < 2; ++ai)
#pragma unroll
            for (int m = 0; m < 4; ++m) { bf16_t* rowp = O + (size_t)(row0 + ai * HALF + m * 16) * ldc + col0;
#pragma unroll
                for (int bj = 0; bj < 2; ++bj) { const f32x4 v0 = acc[ai][bj][m][0] * sc, v1 = acc[ai][bj][m][1] * sc;
                    mx = fmaxf(mx, fmaxf(fmaxf(fmaxf(fabsf(v0[0]), fabsf(v0[1])), fmaxf(fabsf(v0[2]), fabsf(v0[3]))), fmaxf(fmaxf(fabsf(v1[0]), fabsf(v1[1])), fmaxf(fabsf(v1[2]), fabsf(v1[3])))));
                    u32x4 w; w.x = cvt_pk_bf16(v0[0], v0[1]); w.y = cvt_pk_bf16(v0[2], v0[3]); w.z = cvt_pk_bf16(v1[0], v1[1]); w.w = cvt_pk_bf16(v1[2], v1[3]);
                    *(u32x4*)(rowp + bj * HALF) = w; } }
        if (amax_word && u.pn * BM >= amax_col0) {
#pragma unroll
            for (int o = 1; o < 64; o <<= 1) mx = fmaxf(mx, __shfl_xor(mx, o));
            if ((threadIdx.x & 63) == 0) __hip_atomic_fetch_max(amax_word, __float_as_uint(mx), __ATOMIC_RELAXED, __HIP_MEMORY_SCOPE_AGENT); }
    }
};
struct EpiF32ResS {
    static constexpr bool PERM = false, AFTER_DRAIN = false;
    float* C; const float* R; int ldc; const float* s1; const float* s2;
    __device__ __forceinline__ void operator()(const f32x4 (&acc)[2][2][4][2], const Unit& u, int wr, int wc, int fr, int fq) const {
        const int row0 = u.pm * BM + wr * 64 + fr, col0 = u.pn * BM + wc * 32 + 4 * fq; const float sc = *s1 * *s2;
#pragma unroll
        for (int ai = 0; ai < 2; ++ai)
#pragma unroll
            for (int m = 0; m < 4; ++m) { const size_t off = (size_t)(row0 + ai * HALF + m * 16) * ldc + col0;
#pragma unroll
                for (int bj = 0; bj < 2; ++bj)
#pragma unroll
                    for (int n = 0; n < 2; ++n) { const f32x4 r = *(const f32x4*)(R + off + bj * HALF + n * 16); *(f32x4*)(C + off + bj * HALF + n * 16) = acc[ai][bj][m][n] * sc + r; } }
    }
};
struct EpiBf16ResS {
    static constexpr bool PERM = true, AFTER_DRAIN = false;
    bf16_t* O; const float* R; int ldc; const float* s1; const float* s2;
    __device__ __forceinline__ void operator()(const f32x4 (&acc)[2][2][4][2], const Unit& u, int wr, int wc, int fr, int fq) const {
        const int row0 = u.pm * BM + wr * 64 + fr, col0 = u.pn * BM + wc * 32 + 8 * fq; const float sc = *s1 * *s2;
#pragma unroll
        for (int ai = 0; ai < 2; ++ai)
#pragma unroll
            for (int m = 0; m < 4; ++m) { const size_t off = (size_t)(row0 + ai * HALF + m * 16) * ldc + col0;
#pragma unroll
                for (int bj = 0; bj < 2; ++bj) { const f32x4 r0 = *(const f32x4*)(R + off + bj * HALF), r1 = *(const f32x4*)(R + off + bj * HALF + 4);
                    const f32x4 v0 = acc[ai][bj][m][0] * sc + r0, v1 = acc[ai][bj][m][1] * sc + r1;
                    u32x4 w; w.x = cvt_pk_bf16(v0[0], v0[1]); w.y = cvt_pk_bf16(v0[2], v0[3]); w.z = cvt_pk_bf16(v1[0], v1[1]); w.w = cvt_pk_bf16(v1[2], v1[3]);
                    *(u32x4*)(O + off + bj * HALF) = w; } }
    }
};
struct EpiBf16Res {
    static constexpr bool PERM = true, AFTER_DRAIN = false;
    bf16_t* O; int ldc;
    __device__ __forceinline__ void operator()(const f32x4 (&acc)[2][2][4][2], const Unit& u, int wr, int wc, int fr, int fq) const {
        const int row0 = u.pm * BM + wr * 64 + fr, col0 = u.pn * BM + wc * 32 + 8 * fq;
#pragma unroll
        for (int ai = 0; ai < 2; ++ai)
#pragma unroll
            for (int m = 0; m < 4; ++m) { bf16_t* rowp = O + (size_t)(row0 + ai * HALF + m * 16) * ldc + col0;
#pragma unroll
                for (int bj = 0; bj < 2; ++bj) { const u32x4 r = *(const u32x4*)(rowp + bj * HALF); const f32x4 v0 = acc[ai][bj][m][0], v1 = acc[ai][bj][m][1];
                    u32x4 w; w.x = cvt_pk_bf16(v0[0] + __uint_as_float(r.x << 16), v0[1] + __uint_as_float(r.x & 0xffff0000u)); w.y = cvt_pk_bf16(v0[2] + __uint_as_float(r.y << 16), v0[3] + __uint_as_float(r.y & 0xffff0000u));
                    w.z = cvt_pk_bf16(v1[0] + __uint_as_float(r.z << 16), v1[1] + __uint_as_float(r.z & 0xffff0000u)); w.w = cvt_pk_bf16(v1[2] + __uint_as_float(r.w << 16), v1[3] + __uint_as_float(r.w & 0xffff0000u));
                    *(u32x4*)(rowp + bj * HALF) = w; } }
    }
};
struct EpiBf16Row {
    static constexpr bool PERM = true, AFTER_DRAIN = false;
    bf16_t* O; int ldc; const float* rs;
    __device__ __forceinline__ void operator()(const f32x4 (&acc)[2][2][4][2], const Unit& u, int wr, int wc, int fr, int fq) const {
        const int row0 = u.pm * BM + wr * 64 + fr, col0 = u.pn * BM + wc * 32 + 8 * fq;
#pragma unroll
        for (int ai = 0; ai < 2; ++ai)
#pragma unroll
            for (int m = 0; m < 4; ++m) { bf16_t* rowp = O + (size_t)(row0 + ai * HALF + m * 16) * ldc + col0; const float r = rs[row0 + ai * HALF + m * 16];
#pragma unroll
                for (int bj = 0; bj < 2; ++bj) { const f32x4 v0 = acc[ai][bj][m][0] * r, v1 = acc[ai][bj][m][1] * r;
                    u32x4 w; w.x = cvt_pk_bf16(v0[0], v0[1]); w.y = cvt_pk_bf16(v0[2], v0[3]); w.z = cvt_pk_bf16(v1[0], v1[1]); w.w = cvt_pk_bf16(v1[2], v1[3]);
                    *(u32x4*)(rowp + bj * HALF) = w; } }
    }
};
template <class Epi, class Sched, bool ALIGN_EPI = false, bool SP2 = false, bool F8 = false>
__device__ __forceinline__ void gemm_phase(PG8_LAS unsigned char* lds, const Gemm g, const Sched& S, const Epi& E) {
    const int tid = threadIdx.x, wid = __builtin_amdgcn_readfirstlane(tid >> 6), lane = tid & 63, wr = wid >> 2, wc = wid & 3, fr = lane & 15, fq = lane >> 4;
    const int K = g.K, nt = K / BK;
    unsigned voffA[2], voffB[2];
#pragma unroll
    for (int i = 0; i < 2; ++i) { int R, C; stage_rc(tid * 16 + i * 8192, R, C); const int Rb = Epi::PERM ? ((R & ~31) + perm32(R & 31)) : R;
        voffA[i] = (unsigned)(R * K + C) * 2u; voffB[i] = (unsigned)(Rb * K + C) * 2u; }
    const size_t kstep = (size_t)(BK * 2);
    const size_t hstep = (size_t)HALF * K * 2;
    const size_t tstep = 2 * hstep;
    const unsigned ldsw = (unsigned)wid * 1024u;
    const int aoff = lds_byte(wr * 64 + fr, fq * 8), boff = lds_byte(wc * 32 + fr, fq * 8);
#define PG8_SA(b, h) (((b) * 2 + (h)) * HTB)
#define PG8_SB(b, h) ((4 + (b) * 2 + (h)) * HTB)
#define PG8_STAGE(bufoff, gbase, voff) do { _Pragma("unroll") for (int _i = 0; _i < 2; ++_i) \
        __builtin_amdgcn_global_load_lds((const unsigned*)((const char*)(gbase) + (voff)[_i]), (PG8_LAS unsigned*)(lds + (bufoff) + ldsw + _i * 8192), 16, 0, 0); } while (0)
#define PG8_LDA(dst, b, h) do { if constexpr (F8) { _Pragma("unroll") for (int m = 0; m < 4; ++m) dst##8[m] = __builtin_shufflevector(*(const PG8_LAS v4i_t*)(lds + PG8_SA(b, h) + aoff + m * 2048), *(const PG8_LAS v4i_t*)(lds + PG8_SA(b, h) + aoff + m * 2048 + 1024), 0, 1, 2, 3, 4, 5, 6, 7); } else { \
        _Pragma("unroll") for (int m = 0; m < 4; ++m) _Pragma("unroll") for (int k = 0; k < 2; ++k) dst[m][k] = *(const PG8_LAS bf16x8*)(lds + PG8_SA(b, h) + aoff + m * 2048 + k * 1024); } } while (0)
#define PG8_LDB(dst, b, h) do { if constexpr (F8) { _Pragma("unroll") for (int n = 0; n < 2; ++n) dst##8[n] = __builtin_shufflevector(*(const PG8_LAS v4i_t*)(lds + PG8_SB(b, h) + boff + n * 2048), *(const PG8_LAS v4i_t*)(lds + PG8_SB(b, h) + boff + n * 2048 + 1024), 0, 1, 2, 3, 4, 5, 6, 7); } else { \
        _Pragma("unroll") for (int n = 0; n < 2; ++n) _Pragma("unroll") for (int k = 0; k < 2; ++k) dst[n][k] = *(const PG8_LAS bf16x8*)(lds + PG8_SB(b, h) + boff + n * 2048 + k * 1024); } } while (0)
#define PG8_MMA(ai, bj, At, Bt) do { __builtin_amdgcn_s_setprio(1); if constexpr (F8) { _Pragma("unroll") for (int m = 0; m < 4; ++m) _Pragma("unroll") for (int n = 0; n < 2; ++n) \
        asm volatile("v_mfma_f32_16x16x128_f8f6f4 %0, %1, %2, %0" : "+v"(acc[ai][bj][m][n]) : "v"(Bt##8[n]), "v"(At##8[m]));     } else { \
        _Pragma("unroll") for (int m = 0; m < 4; ++m) _Pragma("unroll") for (int n = 0; n < 2; ++n) _Pragma("unroll") for (int k = 0; k < 2; ++k) \
        acc[ai][bj][m][n] = __builtin_amdgcn_mfma_f32_16x16x32_bf16(Bt[n][k], At[m][k], acc[ai][bj][m][n], 0, 0, 0); } __builtin_amdgcn_s_setprio(0); } while (0)
#define PG8_WAIT_V(n) asm volatile("s_waitcnt vmcnt(" #n ")" ::: "memory")
#define PG8_WAIT_L(n) asm volatile("s_waitcnt lgkmcnt(" #n ")" ::: "memory")
#define PG8_BAR __builtin_amdgcn_s_barrier()
#define PG8_SCHED __builtin_amdgcn_sched_barrier(0)
    Unit cur, nxt; int ui = 0;
    if (!S.next(0, cur)) return;
    f32x4 acc[2][2][4][2];
#pragma unroll
    for (int a = 0; a < 2; ++a)
#pragma unroll
        for (int b = 0; b < 2; ++b)
#pragma unroll
            for (int m = 0; m < 4; ++m)
#pragma unroll
                for (int n = 0; n < 2; ++n) acc[a][b][m][n] = (f32x4){0.f, 0.f, 0.f, 0.f};
    const int mxone = 0x7f7f7f7f;
    bf16x8 At[4][2], B0[2][2], B1[2][2]; v8i_t At8[4], B08[2], B18[2];
    const char* cA = (const char*)g.A + (size_t)cur.pm * tstep; const char* cB = (const char*)g.Bt + (size_t)cur.pn * tstep;
    S.a_ready(cur);
    if constexpr (SP2) {
        PG8_STAGE(PG8_SB(0, 0), cB, voffB); PG8_STAGE(PG8_SB(0, 1), cB + hstep, voffB); PG8_STAGE(PG8_SA(0, 0), cA, voffA); PG8_STAGE(PG8_SA(0, 1), cA + hstep, voffA);
        if (wr == 1) PG8_BAR;
        PG8_WAIT_V(2); PG8_BAR;
        PG8_STAGE(PG8_SB(1, 0), cB + kstep, voffB); PG8_STAGE(PG8_SA(1, 0), cA + kstep, voffA); PG8_STAGE(PG8_SB(1, 1), cB + hstep + kstep, voffB);
        PG8_WAIT_V(6); PG8_BAR;
    } else {
        PG8_STAGE(PG8_SB(0, 0), cB, voffB); PG8_STAGE(PG8_SA(0, 0), cA, voffA); PG8_STAGE(PG8_SB(0, 1), cB + hstep, voffB); PG8_STAGE(PG8_SA(0, 1), cA + hstep, voffA);
        if (wr == 1) PG8_BAR;
        PG8_WAIT_V(4); PG8_BAR;
        PG8_STAGE(PG8_SB(1, 0), cB + kstep, voffB); PG8_STAGE(PG8_SA(1, 0), cA + kstep, voffA); PG8_STAGE(PG8_SB(1, 1), cB + hstep + kstep, voffB);
        PG8_WAIT_V(6); PG8_BAR;
    }
    for (;;) {
        const bool has_next = S.next(ui + 1, nxt);
        const char* nA = has_next ? (const char*)g.A + (size_t)nxt.pm * tstep : cA; const char* nB = has_next ? (const char*)g.Bt + (size_t)nxt.pn * tstep : cB;
        for (int t = 0; t < nt; t += 2) {
            const bool last = (t == nt - 2);
            const char* a1 = cA + (size_t)(t + 1) * kstep;
            const char* a2 = last ? nA : cA + (size_t)(t + 2) * kstep; const char* b2 = last ? nB : cB + (size_t)(t + 2) * kstep;
            const char* a3 = a2 + kstep; const char* b3 = b2 + kstep;
            if (last && has_next) S.a_ready(nxt);
            if constexpr (SP2) {
            PG8_LDB(B0, 0, 0); PG8_LDB(B1, 0, 1); PG8_SCHED; PG8_LDA(At, 0, 0); PG8_STAGE(PG8_SA(1, 1), a1 + hstep, voffA);
            PG8_WAIT_V(8); PG8_WAIT_L(0); PG8_BAR; PG8_MMA(0, 0, At, B0); PG8_MMA(0, 1, At, B1); PG8_BAR; PG8_SCHED;
            PG8_LDA(At, 0, 1); PG8_STAGE(PG8_SB(0, 0), b2, voffB); PG8_STAGE(PG8_SB(0, 1), b2 + hstep, voffB); PG8_STAGE(PG8_SA(0, 0), a2, voffA);
            PG8_WAIT_V(8); PG8_WAIT_L(0); PG8_BAR; PG8_MMA(1, 0, At, B0); PG8_MMA(1, 1, At, B1); PG8_BAR; PG8_SCHED;
            PG8_LDB(B0, 1, 0); PG8_LDB(B1, 1, 1); PG8_SCHED; PG8_LDA(At, 1, 0); PG8_STAGE(PG8_SA(0, 1), a2 + hstep, voffA);
            PG8_WAIT_V(8); PG8_WAIT_L(0); PG8_BAR; PG8_MMA(0, 0, At, B0); PG8_MMA(0, 1, At, B1); PG8_BAR; PG8_SCHED;
            PG8_LDA(At, 1, 1); PG8_STAGE(PG8_SB(1, 0), b3, voffB); PG8_STAGE(PG8_SB(1, 1), b3 + hstep, voffB); PG8_STAGE(PG8_SA(1, 0), a3, voffA);
            PG8_WAIT_V(8); PG8_WAIT_L(0); PG8_BAR; PG8_MMA(1, 0, At, B0); PG8_MMA(1, 1, At, B1); PG8_BAR; PG8_SCHED;
            } else {
            PG8_LDB(B0, 0, 0); PG8_SCHED; PG8_LDA(At, 0, 0); PG8_STAGE(PG8_SA(1, 1), a1 + hstep, voffA);
            PG8_WAIT_L(8); PG8_BAR; PG8_WAIT_L(0); PG8_MMA(0, 0, At, B0); PG8_BAR; PG8_SCHED;
            PG8_LDB(B1, 0, 1); PG8_STAGE(PG8_SB(0, 0), b2, voffB);
            PG8_BAR; PG8_WAIT_L(0); PG8_MMA(0, 1, At, B1); PG8_BAR;
            PG8_LDA(At, 0, 1); PG8_STAGE(PG8_SA(0, 0), a2, voffA);
            PG8_BAR; PG8_WAIT_L(0); PG8_MMA(1, 0, At, B0); PG8_BAR; PG8_SCHED;
            PG8_STAGE(PG8_SB(0, 1), b2 + hstep, voffB);
            PG8_WAIT_V(6); PG8_BAR; PG8_MMA(1, 1, At, B1); PG8_BAR;
            PG8_LDB(B0, 1, 0); PG8_SCHED; PG8_LDA(At, 1, 0); PG8_STAGE(PG8_SA(0, 1), a2 + hstep, voffA);
            PG8_WAIT_L(8); PG8_BAR; PG8_WAIT_L(0); PG8_MMA(0, 0, At, B0); PG8_BAR; PG8_SCHED;
            PG8_LDB(B1, 1, 1); PG8_STAGE(PG8_SB(1, 0), b3, voffB);
            PG8_BAR; PG8_WAIT_L(0); PG8_MMA(0, 1, At, B1); PG8_BAR;
            PG8_LDA(At, 1, 1); PG8_STAGE(PG8_SA(1, 0), a3, voffA);
            PG8_BAR; PG8_WAIT_L(0); PG8_MMA(1, 0, At, B0); PG8_BAR; PG8_SCHED;
            PG8_STAGE(PG8_SB(1, 1), b3 + hstep, voffB);
            PG8_WAIT_V(6); PG8_BAR; PG8_MMA(1, 1, At, B1); PG8_BAR;
            }
        }
        if constexpr (ALIGN_EPI) { if (wr == 0) PG8_BAR; }
        if constexpr (F8) asm volatile("s_nop 15\n\ts_nop 15" ::: "memory");
        if constexpr (!Epi::AFTER_DRAIN) { E(acc, cur, wr, wc, fr, fq); S.done(cur); }
        if (!has_next) break;
#pragma unroll
        for (int a = 0; a < 2; ++a)
#pragma unroll
            for (int b = 0; b < 2; ++b)
#pragma unroll
                for (int m = 0; m < 4; ++m)
#pragma unroll
                    for (int n = 0; n < 2; ++n) acc[a][b][m][n] = (f32x4){0.f, 0.f, 0.f, 0.f};
        cur = nxt; cA = nA; cB = nB; ++ui;
        if constexpr (ALIGN_EPI) { if (wr == 1) PG8_BAR; }
    }
    PG8_WAIT_V(0);
    if constexpr (!ALIGN_EPI) { if (wr == 0) PG8_BAR; }
    PG8_BAR;
    if constexpr (Epi::AFTER_DRAIN) { E.fused(acc, cur, wr, wc, fr, fq, lds, wid, lane); S.done(cur); }
#undef PG8_SA
#undef PG8_SB
#undef PG8_STAGE
#undef PG8_LDA
#undef PG8_LDB
#undef PG8_MMA
#undef PG8_WAIT_V
#undef PG8_WAIT_L
#undef PG8_BAR
#undef PG8_SCHED
}
}
namespace att {
using bf16 = unsigned short;
constexpr int   D = 128, NW = 8, QBLK = 32, KVBLK = 64;
constexpr float SCALE = 0.088388347648318440f;
constexpr float THR = 2.f;
constexpr float PSC = 32.f, LPSC = 5.f;
constexpr int LDQ = 5120, LDV = 1024, LDO = 4096;
constexpr int KP = 144;
constexpr float QKS = 1.0f / 256.0f;
constexpr size_t SHM_V = KVBLK * D, SHM_K = KVBLK * KP, SHM_ATTN = 2 * SHM_V + 2 * SHM_K + NW * 64 * 4;
constexpr size_t SHM_OST = 68 * 1024;
constexpr size_t SHM_TOTAL = SHM_OST + NW * 8192;
using bf16x8 = __attribute__((ext_vector_type(8))) short;
using s16x4  = __attribute__((ext_vector_type(4))) short;
using f32x16 = __attribute__((ext_vector_type(16))) float;
using u32x4  = __attribute__((ext_vector_type(4))) unsigned;
using v4i_t  = __attribute__((ext_vector_type(4))) int;
using v8i_t  = __attribute__((ext_vector_type(8))) int;
using v2i_t  = __attribute__((ext_vector_type(2))) int;
using f32x2  = __attribute__((ext_vector_type(2))) float;
#define KSWZ(row, colB) ((row) * 256 + ((colB) ^ (((row) & 7) << 4)))
#define SBAR() __builtin_amdgcn_sched_barrier(0)
__device__ __forceinline__ int crow(int r, int hi) { return (r & 3) + 8 * (r >> 2) + 4 * hi; }
__device__ __forceinline__ unsigned cvtpk(float lo, float hi) {
  unsigned r; asm volatile("v_cvt_pk_bf16_f32 %0, %1, %2" : "=v"(r) : "v"(lo), "v"(hi)); return r;
}
__device__ __forceinline__ bf16x8 ld8(const bf16* p) { return *reinterpret_cast<const bf16x8*>(p); }

__device__ __forceinline__ void partialSM(f32x16& p0, f32x16& p1, float& m_reg, float& mn, float& alpha) {
  constexpr float C = SCALE * QKS * 1.4426950408889634f;
  float pmax = p0[0]; for (int r = 1; r < 16; ++r) pmax = fmaxf(pmax, p0[r]); for (int r = 0; r < 16; ++r) pmax = fmaxf(pmax, p1[r]);
  { auto rr = __builtin_amdgcn_permlane32_swap(__float_as_uint(pmax), __float_as_uint(pmax), false, false);
    pmax = fmaxf(__uint_as_float(rr[0]), __uint_as_float(rr[1])); }
  if (__builtin_expect(__all(pmax - m_reg <= THR / (SCALE * QKS)), 1)) { mn = m_reg; alpha = 1.f; }
  else { mn = fmaxf(m_reg, pmax); alpha = __builtin_amdgcn_exp2f((m_reg - mn) * C); m_reg = mn; }
  const float mnC = fmaf(-mn, C, LPSC);
  p0 = p0 * C + mnC; p1 = p1 * C + mnC;
  for (int r = 0; r < 16; ++r) p0[r] = __builtin_amdgcn_exp2f(p0[r]);
}
__device__ __forceinline__ unsigned pk4f8(float a, float b, float c, float d) { int u; asm volatile("" : "=v"(u));   int p = __builtin_amdgcn_cvt_pk_fp8_f32(a, b, u, false); return (unsigned)__builtin_amdgcn_cvt_pk_fp8_f32(c, d, p, true); }
__device__ __forceinline__ float rowsum32(const f32x16& p0, const f32x16& p1) {
  f32x2 sa = {p0[0], p0[1]}, sb = {p0[2], p0[3]};
#pragma unroll
  for (int r = 2; r < 8; r += 2) { sa += (f32x2){p0[2 * r], p0[2 * r + 1]}; sb += (f32x2){p0[2 * r + 2], p0[2 * r + 3]}; }
#pragma unroll
  for (int r = 0; r < 8; r += 2) { sa += (f32x2){p1[2 * r], p1[2 * r + 1]}; sb += (f32x2){p1[2 * r + 2], p1[2 * r + 3]}; }
  sa += sb; return sa[0] + sa[1]; }
__device__ __forceinline__ void finishSM(f32x16& p0, f32x16& p1, float alpha, float& l_reg, v8i_t& pa) {
  for (int r = 0; r < 16; ++r) p1[r] = __builtin_amdgcn_exp2f(p1[r]);
  float ps = rowsum32(p0, p1);
  { auto rr = __builtin_amdgcn_permlane32_swap(__float_as_uint(ps), __float_as_uint(ps), false, false);
    ps = __uint_as_float(rr[0]) + __uint_as_float(rr[1]); }
  l_reg = l_reg * alpha + ps;
#pragma unroll
  for (int d = 0; d < 4; ++d) { const unsigned x0 = pk4f8(p0[4 * d], p0[4 * d + 1], p0[4 * d + 2], p0[4 * d + 3]), x1 = pk4f8(p1[4 * d], p1[4 * d + 1], p1[4 * d + 2], p1[4 * d + 3]);
    auto rr = __builtin_amdgcn_permlane32_swap(x0, x1, false, false); pa[d] = (int)rr[0]; pa[4 + d] = (int)rr[1]; }
}
__device__ __forceinline__ void qkt(f32x16& p0, f32x16& p1, const char* Ks, const v8i_t* qr, int r32, int hi) {
  p0 = f32x16{}; p1 = f32x16{};
  const char* k0 = Ks + r32 * KP + hi * 32;
#pragma unroll
  for (int ks = 0; ks < 2; ++ks) {
    const v8i_t a0 = __builtin_shufflevector(*reinterpret_cast<const v4i_t*>(k0 + ks * 64), *reinterpret_cast<const v4i_t*>(k0 + ks * 64 + 16), 0, 1, 2, 3, 4, 5, 6, 7);
    const v8i_t a1 = __builtin_shufflevector(*reinterpret_cast<const v4i_t*>(k0 + 32 * KP + ks * 64), *reinterpret_cast<const v4i_t*>(k0 + 32 * KP + ks * 64 + 16), 0, 1, 2, 3, 4, 5, 6, 7);
    p0 = __builtin_amdgcn_mfma_scale_f32_32x32x64_f8f6f4(a0, qr[ks], p0, 0, 0, 0, 0, 0, 0);
    p1 = __builtin_amdgcn_mfma_scale_f32_32x32x64_f8f6f4(a1, qr[ks], p1, 0, 0, 0, 0, 0, 0); }
}
__device__ __forceinline__ int vf(int k) { return ((k >> 1) & 1) | (((k >> 3) & 1) << 1); }
template <int OFF> __device__ __forceinline__ v2i_t tr8_read(int vb) {
  v2i_t r; asm volatile("ds_read_b64_tr_b8 %0, %1 offset:%2" : "=&v"(r) : "v"(vb), "i"(OFF) : "memory"); return r;
}
template <int BUFOFF> __device__ __forceinline__ void pv_blk(f32x16& od, int vb, const v8i_t& pa) {
  const v2i_t t0 = tr8_read<BUFOFF>(vb), t1 = tr8_read<BUFOFF + 16 * 128>(vb), t2 = tr8_read<BUFOFF + 4 * 128>(vb), t3 = tr8_read<BUFOFF + 20 * 128>(vb);
  asm volatile("s_waitcnt lgkmcnt(0)" ::: "memory"); SBAR();
  const v8i_t b = {t0[0], t0[1], t1[0], t1[1], t2[0], t2[1], t3[0], t3[1]};
  od = __builtin_amdgcn_mfma_scale_f32_32x32x64_f8f6f4(pa, b, od, 0, 0, 0, 0, 0, 0);
}
template <int BUFOFF> __device__ __forceinline__ void pv_d0(f32x16* o, const int (&vb)[4], const v8i_t& pa) {
  pv_blk<BUFOFF>(o[0], vb[0], pa); pv_blk<BUFOFF>(o[1], vb[1], pa); pv_blk<BUFOFF>(o[2], vb[2], pa); pv_blk<BUFOFF>(o[3], vb[3], pa);
}

#define ATT_LAS __attribute__((address_space(3)))
template <int OFF> __device__ __forceinline__ v8i_t vread(int vb) {
  const v2i_t t0 = __builtin_amdgcn_ds_read_tr8_b64_v2i32((ATT_LAS v2i_t*)(unsigned)(vb + OFF)), t1 = __builtin_amdgcn_ds_read_tr8_b64_v2i32((ATT_LAS v2i_t*)(unsigned)(vb + OFF + 16 * 128)),
              t2 = __builtin_amdgcn_ds_read_tr8_b64_v2i32((ATT_LAS v2i_t*)(unsigned)(vb + OFF + 4 * 128)), t3 = __builtin_amdgcn_ds_read_tr8_b64_v2i32((ATT_LAS v2i_t*)(unsigned)(vb + OFF + 20 * 128));
  return (v8i_t){t0[0], t0[1], t1[0], t1[1], t2[0], t2[1], t3[0], t3[1]};
}
#define ATT_MFMA(a, b, c) __builtin_amdgcn_mfma_scale_f32_32x32x64_f8f6f4(a, b, c, 0, 0, 0, 0, 0, 0)
#define ATT_CAT(x, y) __builtin_shufflevector(x, y, 0, 1, 2, 3, 4, 5, 6, 7)
template <int KOFF, int VOFF>
__device__ __forceinline__ void stepX(f32x16& pc0, f32x16& pc1, float alc, float& l_reg, v8i_t& pa, f32x16& pn0, f32x16& pn1, v8i_t& vA, const char* K_lds, int vb0, const v8i_t* qr, int r32, int hi) {
  const char* k0 = K_lds + KOFF + r32 * KP + hi * 32;
  const v4i_t k00 = *reinterpret_cast<const v4i_t*>(k0), k01 = *reinterpret_cast<const v4i_t*>(k0 + 16), k10 = *reinterpret_cast<const v4i_t*>(k0 + 32 * KP), k11 = *reinterpret_cast<const v4i_t*>(k0 + 32 * KP + 16);
  const v4i_t k20 = *reinterpret_cast<const v4i_t*>(k0 + 64), k21 = *reinterpret_cast<const v4i_t*>(k0 + 80), k30 = *reinterpret_cast<const v4i_t*>(k0 + 32 * KP + 64), k31 = *reinterpret_cast<const v4i_t*>(k0 + 32 * KP + 80);
  vA = vread<VOFF>(vb0);
  SBAR();
#pragma unroll
  for (int r = 0; r < 16; ++r) pc1[r] = __builtin_amdgcn_exp2f(pc1[r]);
  SBAR();
  pn0 = ATT_MFMA(ATT_CAT(k00, k01), qr[0], (f32x16){});
  SBAR();
  float ps = rowsum32(pc0, pc1);
  SBAR();
  pn1 = ATT_MFMA(ATT_CAT(k10, k11), qr[0], (f32x16){});
  SBAR();
  { auto rr = __builtin_amdgcn_permlane32_swap(__float_as_uint(ps), __float_as_uint(ps), false, false); ps = __uint_as_float(rr[0]) + __uint_as_float(rr[1]); }
  l_reg = l_reg * alc + ps;
  unsigned x0[4], x1[4];
#pragma unroll
  for (int d = 0; d < 4; ++d) x0[d] = pk4f8(pc0[4 * d], pc0[4 * d + 1], pc0[4 * d + 2], pc0[4 * d + 3]);
  SBAR();
  pn0 = ATT_MFMA(ATT_CAT(k20, k21), qr[1], pn0);
  SBAR();
#pragma unroll
  for (int d = 0; d < 4; ++d) x1[d] = pk4f8(pc1[4 * d], pc1[4 * d + 1], pc1[4 * d + 2], pc1[4 * d + 3]);
  SBAR();
  pn1 = ATT_MFMA(ATT_CAT(k30, k31), qr[1], pn1);
  SBAR();
#pragma unroll
  for (int d = 0; d < 4; ++d) { auto rr = __builtin_amdgcn_permlane32_swap(x0[d], x1[d], false, false); pa[d] = (int)rr[0]; pa[4 + d] = (int)rr[1]; }
}
template <int VOFF>
__device__ __forceinline__ void stepY(f32x16* o, const v8i_t& pa, v8i_t& vA, const int (&vb)[4], f32x16& pn0, f32x16& pn1, float& m_reg, float& mn, float& alpha) {
  constexpr float C = SCALE * QKS * 1.4426950408889634f;
  v8i_t vB = vread<VOFF>(vb[1]);
  o[0] = ATT_MFMA(pa, vA, o[0]);
  SBAR();
  float pmax = pn0[0];
#pragma unroll
  for (int r = 1; r < 16; ++r) pmax = fmaxf(pmax, pn0[r]);
  SBAR();
  vA = vread<VOFF>(vb[2]);
  o[1] = ATT_MFMA(pa, vB, o[1]);
  SBAR();
#pragma unroll
  for (int r = 0; r < 16; ++r) pmax = fmaxf(pmax, pn1[r]);
  { auto rr = __builtin_amdgcn_permlane32_swap(__float_as_uint(pmax), __float_as_uint(pmax), false, false); pmax = fmaxf(__uint_as_float(rr[0]), __uint_as_float(rr[1])); }
  const bool keep = __all(pmax - m_reg <= THR / (SCALE * QKS));
  mn = keep ? m_reg : fmaxf(m_reg, pmax); alpha = __builtin_amdgcn_exp2f((m_reg - mn) * C); m_reg = mn;
  const float mnC = fmaf(-mn, C, LPSC);
  SBAR();
  vB = vread<VOFF>(vb[3]);
  o[2] = ATT_MFMA(pa, vA, o[2]);
  SBAR();
  pn0 = pn0 * C + mnC; pn1 = pn1 * C + mnC;
  SBAR();
  o[3] = ATT_MFMA(pa, vB, o[3]);
  SBAR();
#pragma unroll
  for (int r = 0; r < 16; ++r) pn0[r] = __builtin_amdgcn_exp2f(pn0[r]);
  asm volatile("" : "+v"(pn0), "+v"(pn1));
}

__device__ __forceinline__ void attn_dense_body(const unsigned char* __restrict__ Qb, const unsigned char* __restrict__ Kh, const unsigned char* __restrict__ Vh,
                                                unsigned char* __restrict__ Ob, int seq, char* lds) {
  const int tid = threadIdx.x, wid = tid >> 6, lane = tid & 63, r32 = lane & 31, hi = lane >> 5;
  char* V_lds = lds; char* K_lds = lds + 2 * SHM_V;
  float* ws = (float*)(lds + 2 * SHM_V + 2 * SHM_K) + wid * 64; float* li_l = ws; float* al_l = ws + 32;
  float m_reg = -1e30f, l_reg = 0; f32x16 o[4] = {}; v8i_t qr[2];
  const unsigned char* Qw = Qb + (long)(wid * QBLK + r32) * LDQ + hi * 32;
#pragma unroll
  for (int ks = 0; ks < 2; ++ks) qr[ks] = __builtin_shufflevector(*reinterpret_cast<const v4i_t*>(Qw + ks * 64), *reinterpret_cast<const v4i_t*>(Qw + ks * 64 + 16), 0, 1, 2, 3, 4, 5, 6, 7);
  const int kkey = tid >> 3, kc = tid & 7, kch = kc * 16, kst = kkey * KP + kch;
  const int vst = kkey * 128 + (((kc >> 1) ^ vf(kkey)) * 32) + (kc & 1) * 16;
  int vb[4];
  { const int i = lane & 15, g = lane >> 4, jj = i >> 1, kb = (jj & 3) + 8 * (jj >> 2) + 32 * (g >> 1), f = ((jj >> 1) & 1) | (((jj >> 2) & 1) << 1);
#pragma unroll
    for (int blk = 0; blk < 4; ++blk) vb[blk] = (int)(uintptr_t)V_lds + kb * 128 + ((blk ^ f) * 32) + (g & 1) * 16 + 8 * (i & 1); }
  struct { v4i_t vs, ks; } sr_[2];
  const unsigned voffV = (unsigned)(kkey * LDV + kch), voffK = (unsigned)(kkey * LDQ + kch);
#define SLOAD(i, k0) do { const unsigned char* vt_ = Vh + (size_t)(k0) * LDV; const unsigned char* kt_ = Kh + (size_t)(k0) * LDQ; \
    sr_[i].vs = *reinterpret_cast<const v4i_t*>(vt_ + voffV); sr_[i].ks = *reinterpret_cast<const v4i_t*>(kt_ + voffK); } while (0)
#define SWRITE(b, i) do { *(v4i_t*)(V_lds + (b) * SHM_V + vst) = sr_[i].vs; *(v4i_t*)(K_lds + (b) * SHM_K + kst) = sr_[i].ks; } while (0)
#define SWAIT() asm volatile("s_waitcnt vmcnt(2)" ::: "memory")
#define RESC(a) do { if (__any((a) < 1.f)) { if (hi == 0) al_l[r32] = (a); asm volatile("s_waitcnt lgkmcnt(0)" ::: "memory"); \
    for (int d = 0; d < 4; ++d) for (int r = 0; r < 16; ++r) o[d][r] *= al_l[crow(r, hi)]; } } while (0)
  f32x16 pA0, pA1, pB0, pB1; float mnA, mnB, alA, alB; v8i_t pa; const int NT = seq / KVBLK;
  constexpr int SE = 0, SO = 1;
  SLOAD(SE, 0); asm volatile("s_waitcnt vmcnt(0)" ::: "memory"); SWRITE(0, SE); __syncthreads();
  qkt(pA0, pA1, K_lds, qr, r32, hi); partialSM(pA0, pA1, m_reg, mnA, alA);
  SLOAD(SO, KVBLK); if (2 < NT) SLOAD(SE, 2 * KVBLK);
  SWAIT(); SWRITE(1, SO); __syncthreads();
  v8i_t vA;
  for (int j = 1; j + 1 < NT; j += 2) {
    SBAR(); stepX<(int)SHM_K, 0>(pA0, pA1, alA, l_reg, pa, pB0, pB1, vA, K_lds, vb[0], qr, r32, hi); SBAR();
    SLOAD(SO, (j + 2) * KVBLK); SBAR();
    stepY<0>(o, pa, vA, vb, pB0, pB1, m_reg, mnB, alB);
    __syncthreads(); SWAIT(); SWRITE(0, SE);
    RESC(alB); __syncthreads();
    SBAR(); stepX<0, (int)SHM_V>(pB0, pB1, alB, l_reg, pa, pA0, pA1, vA, K_lds, vb[0], qr, r32, hi); SBAR();
    SLOAD(SE, (j + 3 < NT ? j + 3 : NT - 1) * KVBLK); SBAR();
    stepY<(int)SHM_V>(o, pa, vA, vb, pA0, pA1, m_reg, mnA, alA);
    __syncthreads(); SWAIT(); SWRITE(1, SO);
    RESC(alA); __syncthreads();
  }
  SBAR(); qkt(pB0, pB1, K_lds + SHM_K, qr, r32, hi);
  finishSM(pA0, pA1, alA, l_reg, pa); SBAR();
  pv_d0<0>(o, vb, pa); partialSM(pB0, pB1, m_reg, mnB, alB);
  __syncthreads(); RESC(alB);
  finishSM(pB0, pB1, alB, l_reg, pa); SBAR();
  pv_d0<(int)SHM_V>(o, vb, pa);
  if (hi == 0) li_l[r32] = l_reg; asm volatile("s_waitcnt lgkmcnt(0)" ::: "memory");
  int tide = tid; asm volatile("" : "+v"(tide));
  const int lanee = tide & 63, wide = tide >> 6, r32e = lanee & 31, hie = lanee >> 5;
  float rli[16];
#pragma unroll
  for (int r = 0; r < 16; ++r) rli[r] = __builtin_amdgcn_rcpf(li_l[crow(r, hi)]);
  char* ost = lds + SHM_OST + wide * 8192 + hie * 512 + r32e;
#pragma unroll
  for (int r = 0; r < 16; ++r) { const float rs = rli[r];
#pragma unroll
    for (int d0 = 0; d0 < 4; ++d0) { const float v = __builtin_amdgcn_fmed3f(o[d0][r] * rs, -448.f, 448.f);
      *(unsigned char*)(ost + ((r & 3) + 8 * (r >> 2)) * 128 + d0 * 32) = (unsigned char)(__builtin_amdgcn_cvt_pk_fp8_f32(v, 0.f, 0, false) & 0xFF); } }
  asm volatile("s_waitcnt lgkmcnt(0)" ::: "memory");
  const char* ord = lds + SHM_OST + wide * 8192 + (lanee >> 3) * 128 + (lanee & 7) * 16;
  unsigned char* Ow = Ob + (long)(wide * QBLK + (lanee >> 3)) * LDO + (lanee & 7) * 16;
#pragma unroll
  for (int i = 0; i < 4; ++i) { const u32x4 w = *(const u32x4*)(ord + i * 1024); *(u32x4*)(Ow + (long)i * 8 * LDO) = w; }
#undef SLOAD
#undef SWRITE
#undef SWAIT
#undef RESC
}
#undef KSWZ
#undef SBAR
}
#ifndef SELNET_HD
#define SELNET_HD __device__ __forceinline__
#endif
namespace seln {
SELNET_HD void ce(float& a, float& b) { const float mx = fmaxf(a, b), mn = fminf(a, b); a = mx; b = mn; }
SELNET_HD void sort16(float (&v)[16]) {
#pragma unroll
    for (int k = 2; k <= 16; k <<= 1) {
#pragma unroll
        for (int j = k >> 1; j > 0; j >>= 1) {
#pragma unroll
            for (int i = 0; i < 16; ++i) { const int l = i ^ j; if (l > i) { if ((i & k) == 0) ce(v[i], v[l]); else ce(v[l], v[i]); } }
        }
    }
}
SELNET_HD void merge16(float (&a)[16], const float (&b)[16]) {
#pragma unroll
    for (int i = 0; i < 16; ++i) a[i] = fmaxf(a[i], b[15 - i]);
#pragma unroll
    for (int j = 8; j > 0; j >>= 1) {
#pragma unroll
        for (int i = 0; i < 16; ++i) { const int l = i ^ j; if (l > i) ce(a[i], a[l]); }
    }
}
SELNET_HD void top16_of_64(float (&v)[4][16]) {
    sort16(v[0]); sort16(v[1]); sort16(v[2]); sort16(v[3]);
    merge16(v[0], v[1]); merge16(v[2], v[3]); merge16(v[0], v[2]);
}
}
constexpr int NWAVES = 8;
#ifndef MK_PER_PHASE
#define MK_PER_PHASE 0
#endif
constexpr int BATCH = 4, SEQ = 4096, DM = 4096, T = BATCH * SEQ, QKVD = 6144, CIN = 3 * DM, PQD = 2048, NEXP = 16384, SLOTS = 128;
constexpr float EPS = 1e-6f;
constexpr size_t MiB = 1u << 20;
constexpr size_t WS_CTL = 0, CTL_ZERO_BYTES = 1 * MiB;
constexpr size_t WS_WQKV = 1 * MiB;
constexpr size_t WS_WO   = WS_WQKV + 48 * MiB;
constexpr size_t WS_WIN  = WS_WO + 32 * MiB;
constexpr size_t WS_WOUT = WS_WIN + 96 * MiB;
constexpr size_t WS_WPQ  = WS_WOUT + 32 * MiB;
constexpr size_t WS_SK   = WS_WPQ + 32 * MiB;
constexpr size_t WS_ROPE = WS_SK + 1 * MiB;
constexpr size_t WS_ISC  = WS_ROPE + 65536;
constexpr size_t WS_U    = WS_ROPE + 1 * MiB;
constexpr size_t WS_V    = WS_U + 128 * MiB;
constexpr size_t WS_HN   = WS_V + 128 * MiB;
constexpr size_t WS_QKV  = WS_HN + 128 * MiB;
constexpr size_t WS_O    = WS_QKV + 192 * MiB;
constexpr size_t WS_PQ   = WS_O + 128 * MiB;
constexpr size_t WS_IDX  = WS_PQ + 64 * MiB;
constexpr size_t WS_GATE = WS_IDX + 8 * MiB;
constexpr size_t WS_BCX  = WS_GATE + 8 * MiB;
constexpr size_t WS_Y    = WS_BCX + 384 * MiB;
constexpr size_t WS_PART = WS_Y + 128 * MiB;
constexpr size_t WS_WQ8  = WS_PART + 128 * MiB;
constexpr size_t WS_END  = WS_WQ8 + 8 * MiB;
constexpr int CW_TMO = 0, CW_BAR = 4096, CW_RANK = 8192, CW_AMAX = 12288;
constexpr int RING_OFF = 0, RING_BYTES = 135168;
constexpr int MISC_OFF = RING_BYTES;
constexpr int VL_OFF = MISC_OFF + 256, VL_WAVE = 2560;
constexpr int LDS_BYTES = 159744;
static_assert(VL_OFF + NWAVES * VL_WAVE <= LDS_BYTES && MISC_OFF + 128 <= LDS_BYTES && (int)att::SHM_TOTAL <= RING_BYTES && pg8::STAGE_BYTES <= RING_BYTES, "LDS map");

#define GAS __attribute__((address_space(1)))
#define LAS __attribute__((address_space(3)))
typedef unsigned short bf16;
typedef unsigned v4u __attribute__((ext_vector_type(4)));
typedef unsigned v2u __attribute__((ext_vector_type(2)));
typedef int v4i __attribute__((ext_vector_type(4)));
typedef float f32x4 __attribute__((ext_vector_type(4)));
typedef float f32x16 __attribute__((ext_vector_type(16)));
typedef short bf16x8 __attribute__((ext_vector_type(8)));
typedef __bf16 bf16x2 __attribute__((ext_vector_type(2)));
typedef GAS unsigned gu32;
#define RLX_AGENT __ATOMIC_RELAXED, __HIP_MEMORY_SCOPE_AGENT
#define LDS_WAIT() asm volatile("s_waitcnt lgkmcnt(0)" ::: "memory")
#define VM_WAIT() asm volatile("s_waitcnt vmcnt(0)" ::: "memory")
__device__ __forceinline__ unsigned f2bf(float f) { unsigned u = __builtin_bit_cast(unsigned, f); return (u + 0x7fffu + ((u >> 16) & 1u)) >> 16; }
__device__ __forceinline__ unsigned pk2(float lo, float hi) { return f2bf(lo) | (f2bf(hi) << 16); }
__device__ __forceinline__ float bflo(unsigned w) { return __uint_as_float(w << 16); }
__device__ __forceinline__ float bfhi(unsigned w) { return __uint_as_float(w & 0xffff0000u); }
__device__ __forceinline__ float dot2(unsigned a, unsigned b, float acc) { return __builtin_amdgcn_fdot2_f32_bf16(__builtin_bit_cast(bf16x2, a), __builtin_bit_cast(bf16x2, b), acc, false); }
__device__ __forceinline__ float wave_sum(float v) {
#pragma unroll
    for (int o = 1; o < 64; o <<= 1) v += __shfl_xor(v, o);
    return v;
}

#define XB_TMO      128
#define XB_XCNT(j)  (256  + 64 * (j))
#define XB_XSUB(j)  (1280 + 64 * (j))
#define XB_XGEN(j)  (2304 + 64 * (j))
#define XB_TOP      3328
#define XB_TOPGEN   3392
#define XCD_BAR_WORDS 3456
#define XB_SPIN_CAP (1u << 18)

__device__ __forceinline__ unsigned xb_ld(unsigned* p)              { return __hip_atomic_load(p, __ATOMIC_RELAXED, __HIP_MEMORY_SCOPE_AGENT); }
__device__ __forceinline__ unsigned xb_add(unsigned* p, unsigned v) { return __hip_atomic_fetch_add(p, v, __ATOMIC_RELAXED, __HIP_MEMORY_SCOPE_AGENT); }
__device__ __forceinline__ unsigned xb_xcc_id() { return (unsigned)__builtin_amdgcn_s_getreg((3 << 11) | 20) & 0xFu; }
#define XB_SPIN(cond, bar) do { unsigned _sp = 0; while (cond) { __builtin_amdgcn_s_sleep(1); \
    if ((++_sp & 255u) == 0u) { if (xb_ld(&(bar)[XB_TMO])) break; if (_sp > XB_SPIN_CAP) { atomicAdd(&(bar)[XB_TMO], 1u); break; } } } } while (0)

struct XcdBarrier {
    unsigned* bar; unsigned x;
    volatile LAS unsigned* st;
};

__device__ __forceinline__ XcdBarrier xcd_barrier_post(unsigned* bar, volatile LAS unsigned* st) {
    XcdBarrier b; b.bar = bar; b.x = xb_xcc_id(); b.st = st;
    if (threadIdx.x == 0) (void)xb_add(&bar[XB_XCNT(b.x)], 1u);
    return b;
}
__device__ __forceinline__ void xcd_barrier_complete(unsigned* bar, unsigned x, unsigned& nloc, unsigned& nx) {
    const unsigned G = gridDim.x * gridDim.y * gridDim.z;
    unsigned sum, cnt, mine, sp = 0u;
    for (;;) {
        sum = 0u; cnt = 0u; mine = 0u;
#pragma unroll
        for (unsigned j = 0; j < 16; ++j) { const unsigned c = xb_ld(&bar[XB_XCNT(j)]); sum += c; cnt += (c > 0u) ? 1u : 0u; mine = (j == x) ? c : mine; }
        if (sum == G) break;
        __builtin_amdgcn_s_sleep(1);
        if ((++sp & 255u) == 0u) { if (xb_ld(&bar[XB_TMO])) break; if (sp > XB_SPIN_CAP) { atomicAdd(&bar[XB_TMO], 1u); break; } }
    }
    nloc = mine > 0u ? mine : 1u; nx = cnt > 0u ? cnt : 1u;
}

__device__ __forceinline__ void xcd_barrier(const XcdBarrier& b) {
    asm volatile("s_waitcnt vmcnt(0)" ::: "memory");
    __syncthreads();
    if (threadIdx.x == 0) {
        unsigned* bar = b.bar;
        __builtin_amdgcn_s_waitcnt(0);
        unsigned nloc = b.st[0], nx = b.st[1];
        if (nloc == 0u) { xcd_barrier_complete(bar, b.x, nloc, nx); b.st[0] = nloc; b.st[1] = nx; }
        const unsigned old = xb_add(&bar[XB_XSUB(b.x)], 1u);
        const unsigned gen = old / nloc;
        if (old + 1u == (gen + 1u) * nloc) {
            __builtin_amdgcn_fence(__ATOMIC_RELEASE, "agent");
            asm volatile("s_waitcnt vmcnt(0)" ::: "memory");
            const unsigned og = xb_add(&bar[XB_TOP], 1u);
            const unsigned tg = og / nx;
            if (og + 1u == (tg + 1u) * nx) xb_add(&bar[XB_TOPGEN], 1u);
            else XB_SPIN(xb_ld(&bar[XB_TOPGEN]) == tg, bar);
            __builtin_amdgcn_fence(__ATOMIC_ACQUIRE, "agent");
            xb_add(&bar[XB_XGEN(b.x)], 1u);
            asm volatile("s_waitcnt vmcnt(0)" ::: "memory");
        } else {
            XB_SPIN(xb_ld(&bar[XB_XGEN(b.x)]) == gen, bar);
            __builtin_amdgcn_fence(__ATOMIC_ACQUIRE, "agent");
            asm volatile("s_waitcnt vmcnt(0)" ::: "memory");
        }
    }
    __syncthreads();
}

typedef float f32x2 __attribute__((ext_vector_type(2)));
typedef int v2i __attribute__((ext_vector_type(2)));
struct Frame { LAS unsigned char* lds; int tid, lane, wave, vcu, G, gw, NGW; };

__device__ __forceinline__ unsigned pack4_fp8(float a, float b, float c, float d) {
    int p = __builtin_amdgcn_cvt_pk_fp8_f32(__builtin_amdgcn_fmed3f(a, -448.f, 448.f), __builtin_amdgcn_fmed3f(b, -448.f, 448.f), 0, false);
    p = __builtin_amdgcn_cvt_pk_fp8_f32(__builtin_amdgcn_fmed3f(c, -448.f, 448.f), __builtin_amdgcn_fmed3f(d, -448.f, 448.f), p, true); return (unsigned)p;
}
__device__ __forceinline__ void amax_tensor(const Frame& F, const float* src, size_t n4, gu32* word) {
    float mx = 0.f; const size_t stride = (size_t)F.NGW * 64;
    for (size_t i = (size_t)F.gw * 64 + F.lane; i < n4; i += stride) { const f32x4 a = ((const GAS f32x4*)src)[i]; mx = fmaxf(mx, fmaxf(fmaxf(fabsf(a.x), fabsf(a.y)), fmaxf(fabsf(a.z), fabsf(a.w)))); }
#pragma unroll
    for (int o = 1; o < 64; o <<= 1) mx = fmaxf(mx, __shfl_xor(mx, o));
    if (F.lane == 0) __hip_atomic_fetch_max(word, __float_as_uint(mx), RLX_AGENT);
}
__device__ __forceinline__ f32x2 pow2_scale(unsigned amax_bits) { const int E = (int)((amax_bits >> 23) & 0xFFu);
    f32x2 r; r.x = (E == 0 || E > 250) ? 1.0f : __uint_as_float((unsigned)(261 - E) << 23); r.y = (E == 0 || E > 250) ? 1.0f : __uint_as_float((unsigned)(E - 7) << 23); return r; }
__device__ __forceinline__ void rms_row_to_fp8(const float* xrow, const float* gain, unsigned char* orow, int lane) {
    const GAS f32x4* xr = (const GAS f32x4*)xrow + lane;
    f32x4 v[16]; float s = 0.f;
#pragma unroll
    for (int j = 0; j < 16; ++j) { v[j] = xr[64 * j]; s += (v[j].x * v[j].x + v[j].y * v[j].y) + (v[j].z * v[j].z + v[j].w * v[j].w); }
    const float r = 16.0f / sqrtf(wave_sum(s) * (1.f / DM) + EPS);
    const GAS f32x4* gr = (const GAS f32x4*)gain + lane; GAS unsigned* o4 = (GAS unsigned*)orow + lane;
#pragma unroll
    for (int j = 0; j < 16; ++j) { const f32x4 g = gr[64 * j]; o4[64 * j] = pack4_fp8(v[j].x * r * g.x, v[j].y * r * g.y, v[j].z * r * g.z, v[j].w * r * g.w); }
}
__device__ __forceinline__ int convin_row(int n) { return n < DM ? n : (n < 2 * DM ? DM + ((n - DM) >> 7) * 256 + ((n - DM) & 127) : DM + ((n - 2 * DM) >> 7) * 256 + 128 + ((n - 2 * DM) & 127)); }
template <bool REMAP, bool F8>
__device__ __forceinline__ void p0_transpose_item(const float* W, int K, int N, void* WTv, LAS float* scr, int item, int lane, float sc, const float* gk) {
    const int nblk = N / 64, kb = item / nblk, nb = item % nblk, k0 = 64 * kb, n0 = 64 * nb;
    const int kr = lane >> 4, nc = lane & 15;
#pragma unroll 4
    for (int i = 0; i < 16; ++i) { const int kk = kr + 4 * i; f32x4 v = *(const GAS f32x4*)(W + (size_t)(k0 + kk) * N + n0 + 4 * nc);
        if (gk) v = v * gk[k0 + kk];
        LAS float* d = scr + kk * 65 + 4 * nc; d[0] = v.x; d[1] = v.y; d[2] = v.z; d[3] = v.w; }
    LDS_WAIT(); asm volatile("" ::: "memory");
    const int c = lane & 7;
#pragma unroll
    for (int j = 0; j < 8; ++j) { const int n = (lane >> 3) + 8 * j; const LAS float* s = scr + (8 * c) * 65 + n; const int orow = REMAP ? convin_row(n0 + n) : (n0 + n);
        if constexpr (F8) { v2u o; o.x = pack4_fp8(s[0 * 65] * sc, s[1 * 65] * sc, s[2 * 65] * sc, s[3 * 65] * sc); o.y = pack4_fp8(s[4 * 65] * sc, s[5 * 65] * sc, s[6 * 65] * sc, s[7 * 65] * sc);
            *(GAS v2u*)((unsigned char*)WTv + (size_t)orow * K + k0 + 8 * c) = o; }
        else { v4u o; o.x = pk2(s[0 * 65], s[1 * 65]); o.y = pk2(s[2 * 65], s[3 * 65]); o.z = pk2(s[4 * 65], s[5 * 65]); o.w = pk2(s[6 * 65], s[7 * 65]);
            *(GAS v4u*)((bf16*)WTv + (size_t)orow * K + k0 + 8 * c) = o; } }
    LDS_WAIT(); asm volatile("" ::: "memory");
}
template <bool REMAP = false, bool F8 = false>
__device__ __forceinline__ void transpose_all(const Frame& F, const float* W, int K, int N, void* WT, float sc = 1.f, const float* gk = nullptr) {
    LAS float* scr = (LAS float*)(F.lds + RING_OFF + F.wave * 16640);
    const int nitems = (K / 64) * (N / 64);
    for (int it = F.gw; it < nitems; it += F.NGW) p0_transpose_item<REMAP, F8>(W, K, N, WT, scr, it, F.lane, sc, gk);
}
__device__ __forceinline__ void cvt_copy(const Frame& F, const float* src, bf16* dst, size_t n8) {
    const size_t stride = (size_t)F.NGW * 64;
    for (size_t i = (size_t)F.gw * 64 + F.lane; i < n8; i += stride) {
        const f32x4 a = ((const GAS f32x4*)src)[2 * i], b = ((const GAS f32x4*)src)[2 * i + 1];
        v4u o; o.x = pk2(a.x, a.y); o.y = pk2(a.z, a.w); o.z = pk2(b.x, b.y); o.w = pk2(b.z, b.w);
        ((GAS v4u*)dst)[i] = o; }
}
__device__ __forceinline__ void cvt_rows_fp8(const Frame& F, const float* src, unsigned char* dst, float* iscale, int nrows) {
    for (int m = F.gw; m < nrows; m += F.NGW) {
        const GAS f32x4* sp = (const GAS f32x4*)(src + (size_t)m * DM + F.lane * 16);
        f32x4 v[4][4]; float mx = 0.f;
#pragma unroll
        for (int jj = 0; jj < 4; ++jj)
#pragma unroll
            for (int q = 0; q < 4; ++q) { v[jj][q] = sp[jj * 256 + q]; mx = fmaxf(mx, fmaxf(fmaxf(fabsf(v[jj][q].x), fabsf(v[jj][q].y)), fmaxf(fabsf(v[jj][q].z), fabsf(v[jj][q].w)))); }
#pragma unroll
        for (int o = 1; o < 64; o <<= 1) mx = fmaxf(mx, __shfl_xor(mx, o));
        const int E = (int)((__float_as_uint(mx) >> 23) & 0xFFu);
        const float sc = (E == 0 || E > 250) ? 1.0f : __uint_as_float((unsigned)(261 - E) << 23), isc = (E == 0 || E > 250) ? 1.0f : __uint_as_float((unsigned)(E - 7) << 23);
        GAS v4u* dp = (GAS v4u*)(dst + (size_t)m * DM + F.lane * 16);
#pragma unroll
        for (int jj = 0; jj < 4; ++jj) { v4u o;
#pragma unroll
            for (int q = 0; q < 4; ++q) { int pk = __builtin_amdgcn_cvt_pk_fp8_f32(v[jj][q].x * sc, v[jj][q].y * sc, 0, false); pk = __builtin_amdgcn_cvt_pk_fp8_f32(v[jj][q].z * sc, v[jj][q].w * sc, pk, true); o[q] = (unsigned)pk; }
            dp[jj * 64] = o; }
        if (F.lane == 0) iscale[m] = isc;
    }
}
template <bool PAIRED>
__device__ __forceinline__ void cvt_rows_fp4(const Frame& F, const float* src, unsigned char* dst, float* iscale, int nrows) {
    for (int m = F.gw; m < nrows; m += F.NGW) {
        const int l0 = PAIRED ? ((F.lane >> 1) * 32 + (F.lane & 1) * 8) : F.lane * 16;
        const GAS f32x4* sp = (const GAS f32x4*)(src + (size_t)m * DM + l0);
        f32x4 v[4][4]; float mx = 0.f;
#pragma unroll
        for (int jj = 0; jj < 4; ++jj)
#pragma unroll
            for (int q = 0; q < 4; ++q) { v[jj][q] = sp[jj * 256 + (PAIRED ? ((q & 1) + 4 * (q >> 1)) : q)]; mx = fmaxf(mx, fmaxf(fmaxf(fabsf(v[jj][q].x), fabsf(v[jj][q].y)), fmaxf(fabsf(v[jj][q].z), fabsf(v[jj][q].w)))); }
#pragma unroll
        for (int o = 1; o < 64; o <<= 1) mx = fmaxf(mx, __shfl_xor(mx, o));
        const int E = (int)((__float_as_uint(mx) >> 23) & 0xFFu);
        const float sc = (E < 8 || E > 250) ? 1.0f : __uint_as_float((unsigned)(256 - E) << 23), isc = (E < 8 || E > 250) ? 1.0f : __uint_as_float((unsigned)(E - 2) << 23);
        GAS v2u* dp = (GAS v2u*)(dst + (size_t)(m / NEXP) * ((size_t)NEXP * (DM / 2)) + (size_t)(F.lane >> 5) * ((size_t)NEXP * 256) + (size_t)(m % NEXP) * 256 + (F.lane & 31) * 8);
#pragma unroll
        for (int jj = 0; jj < 4; ++jj) { float e[16];
#pragma unroll
            for (int q = 0; q < 4; ++q) { e[4 * q] = __builtin_amdgcn_fmed3f(v[jj][q].x * sc, -6.f, 6.f); e[4 * q + 1] = __builtin_amdgcn_fmed3f(v[jj][q].y * sc, -6.f, 6.f); e[4 * q + 2] = __builtin_amdgcn_fmed3f(v[jj][q].z * sc, -6.f, 6.f); e[4 * q + 3] = __builtin_amdgcn_fmed3f(v[jj][q].w * sc, -6.f, 6.f); }
            v2u o; unsigned w = 0u;
#define F4B(B, SEL) w = __builtin_amdgcn_cvt_scalef32_pk_fp4_f32(w, PAIRED ? e[(B)] : e[2 * (B)], PAIRED ? e[8 + (B)] : e[2 * (B) + 1], 1.0f, SEL)
            F4B(0, 0); F4B(1, 1); F4B(2, 2); F4B(3, 3); o.x = w; w = 0u; F4B(4, 0); F4B(5, 1); F4B(6, 2); F4B(7, 3); o.y = w;
#undef F4B
            dp[(size_t)jj * (2 * NEXP * 256 / 8)] = o; }
        if (F.lane == 0) iscale[m] = isc;
    }
}
__device__ __forceinline__ void rms_row_to_bf16(const float* xrow, const float* gain, bf16* orow, int lane) {
    const GAS f32x4* xr = (const GAS f32x4*)xrow + lane;
    f32x4 v[16]; float s = 0.f;
#pragma unroll
    for (int j = 0; j < 16; ++j) { v[j] = xr[64 * j]; s += (v[j].x * v[j].x + v[j].y * v[j].y) + (v[j].z * v[j].z + v[j].w * v[j].w); }
    const float r = 1.0f / sqrtf(wave_sum(s) * (1.f / DM) + EPS);
    const GAS f32x4* gr = (const GAS f32x4*)gain + lane; GAS v2u* o8 = (GAS v2u*)orow + lane;
#pragma unroll
    for (int j = 0; j < 16; ++j) { const f32x4 g = gr[64 * j]; v2u o; o.x = pk2(v[j].x * r * g.x, v[j].y * r * g.y); o.y = pk2(v[j].z * r * g.z, v[j].w * r * g.w); o8[64 * j] = o; }
}
__device__ __forceinline__ void norm_phase(const Frame& F, const float* src, const float* gain, bf16* dst) {
    for (int m = F.gw; m < T; m += F.NGW) rms_row_to_bf16(src + (size_t)m * DM, gain, dst + (size_t)m * DM, F.lane);
}
__device__ __forceinline__ void norm_phase_x8(const Frame& F, const float* src, const float* gain, bf16* dst, unsigned char* xh, unsigned char* xl) {
    for (int m = F.gw; m < T; m += F.NGW) {
        const GAS f32x4* xr = (const GAS f32x4*)(src + (size_t)m * DM) + F.lane;
        f32x4 v[16]; float s = 0.f;
#pragma unroll
        for (int j = 0; j < 16; ++j) { v[j] = xr[64 * j]; s += (v[j].x * v[j].x + v[j].y * v[j].y) + (v[j].z * v[j].z + v[j].w * v[j].w); }
        const float r = 1.0f / sqrtf(wave_sum(s) * (1.f / DM) + EPS);
        const GAS f32x4* gr = (const GAS f32x4*)gain + F.lane; GAS v2u* o8 = (GAS v2u*)(dst + (size_t)m * DM) + F.lane;
        GAS unsigned* oh = (GAS unsigned*)(xh + (size_t)m * DM) + F.lane; (void)xl;
#pragma unroll
        for (int j = 0; j < 16; ++j) { const f32x4 g = gr[64 * j]; const float a0 = v[j].x * r * g.x, a1 = v[j].y * r * g.y, a2 = v[j].z * r * g.z, a3 = v[j].w * r * g.w;
            v2u o; o.x = pk2(a0, a1); o.y = pk2(a2, a3); o8[64 * j] = o;
            const unsigned hh = pack4_fp8(16.f * a0, 16.f * a1, 16.f * a2, 16.f * a3);
            oh[64 * j] = hh; }
    }
}
__device__ __forceinline__ void norm_row_b(const bf16* xrow, int lane, f32x4 (&v)[8][2], float& r) {
    const GAS v4u* xr = (const GAS v4u*)xrow + lane; float s = 0.f;
#pragma unroll
    for (int j = 0; j < 8; ++j) { const v4u w = xr[64 * j]; v[j][0] = (f32x4){bflo(w.x), bfhi(w.x), bflo(w.y), bfhi(w.y)}; v[j][1] = (f32x4){bflo(w.z), bfhi(w.z), bflo(w.w), bfhi(w.w)};
        s += (v[j][0].x * v[j][0].x + v[j][0].y * v[j][0].y) + (v[j][0].z * v[j][0].z + v[j][0].w * v[j][0].w) + (v[j][1].x * v[j][1].x + v[j][1].y * v[j][1].y) + (v[j][1].z * v[j][1].z + v[j][1].w * v[j][1].w); }
    r = 1.0f / sqrtf(wave_sum(s) * (1.f / DM) + EPS);
}
template <bool X8>
__device__ __forceinline__ void norm_phase_b(const Frame& F, const bf16* src, const float* gain, float* rs, unsigned char* xh) {
    for (int m = F.gw; m < T; m += F.NGW) {
        f32x4 v[8][2]; float r; norm_row_b(src + (size_t)m * DM, F.lane, v, r);
        if (F.lane == 0) rs[m] = r;
        if constexpr (X8) { const GAS f32x4* gr = (const GAS f32x4*)gain + 2 * F.lane; GAS v2u* oh = (GAS v2u*)(xh + (size_t)m * DM) + F.lane; const float r16 = 16.f * r;
#pragma unroll
            for (int j = 0; j < 8; ++j) { const f32x4 g0 = gr[128 * j], g1 = gr[128 * j + 1];
                v2u h8; h8.x = pack4_fp8(v[j][0].x * r16 * g0.x, v[j][0].y * r16 * g0.y, v[j][0].z * r16 * g0.z, v[j][0].w * r16 * g0.w); h8.y = pack4_fp8(v[j][1].x * r16 * g1.x, v[j][1].y * r16 * g1.y, v[j][1].z * r16 * g1.z, v[j][1].w * r16 * g1.w);
                oh[64 * j] = h8; } }
    }
}
__device__ __forceinline__ void rope_table(const Frame& F, float* tab) {
    for (int e = F.tid; e < 2048; e += NWAVES * 64) {
        const int idx = e >> 5, f = e & 31;
        const float inv = powf(10000.0f, -(float)(2 * f) / 64.0f);
        const float angf = (float)idx * inv;
        double x = (double)angf; const double k = rint(x * 0.15915494309189535); x -= k * 6.283185307179586477;
        const double x2 = x * x; double cs = 1.0, sn = x, tc = 1.0, ts = x;
#pragma unroll 1
        for (int n = 1; n <= 16; ++n) { tc *= -x2 / (double)((2 * n - 1) * (2 * n)); ts *= -x2 / (double)((2 * n) * (2 * n + 1)); cs += tc; sn += ts; }
        tab[e] = (float)cs; tab[2048 + e] = (float)sn; }
}

__device__ __forceinline__ void qknorm_rope_phase(const Frame& F, const bf16* qkv, unsigned char* qk8, unsigned char* v8, const float* qg, const float* kg, const float* tab, gu32* vmax_word) {
    { const float sv = pow2_scale(__hip_atomic_load(vmax_word, RLX_AGENT)).x;
      for (int m = F.gw; m < T; m += F.NGW) { const GAS v4u* vp = (const GAS v4u*)(qkv + (size_t)m * QKVD + 5120 + F.lane * 16); const v4u a = vp[0], b = vp[1];
          v4u o; o.x = pack4_fp8(bflo(a.x) * sv, bfhi(a.x) * sv, bflo(a.y) * sv, bfhi(a.y) * sv); o.y = pack4_fp8(bflo(a.z) * sv, bfhi(a.z) * sv, bflo(a.w) * sv, bfhi(a.w) * sv);
          o.z = pack4_fp8(bflo(b.x) * sv, bfhi(b.x) * sv, bflo(b.y) * sv, bfhi(b.y) * sv); o.w = pack4_fp8(bflo(b.z) * sv, bfhi(b.z) * sv, bflo(b.w) * sv, bfhi(b.w) * sv);
          *(GAS v4u*)(v8 + (size_t)m * 1024 + F.lane * 16) = o; } }
    const int lane = F.lane, hh = lane >> 3, sub = lane & 7, axis = sub >> 2, f0 = (sub & 3) * 8;
    for (int it = F.gw; it < T * 5; it += F.NGW) {
        const int t = it / 5, grp = it - t * 5, head = grp * 8 + hh;
        const bf16* p1 = qkv + (size_t)t * QKVD + head * 128 + axis * 64 + f0; const bf16* p2 = p1 + 32;
        const v4u a = *(const GAS v4u*)p1, b = *(const GAS v4u*)p2;
        float x1[8] = {bflo(a.x), bfhi(a.x), bflo(a.y), bfhi(a.y), bflo(a.z), bfhi(a.z), bflo(a.w), bfhi(a.w)};
        float x2[8] = {bflo(b.x), bfhi(b.x), bflo(b.y), bfhi(b.y), bflo(b.z), bfhi(b.z), bflo(b.w), bfhi(b.w)};
        float ss = 0.f;
#pragma unroll
        for (int i = 0; i < 8; ++i) ss += x1[i] * x1[i] + x2[i] * x2[i];
        ss += __shfl_xor(ss, 1); ss += __shfl_xor(ss, 2); ss += __shfl_xor(ss, 4);
        const float r = 1.0f / sqrtf(ss * (1.f / 128.f) + EPS);
        const float* g = (head < 32 ? qg : kg) + axis * 64 + f0;
        const int s = t & (SEQ - 1), idx = axis ? (s & 63) : (s >> 6);
        const float* ct = tab + idx * 32 + f0; const float* st = ct + 2048;
        float o1[8], o2[8];
#pragma unroll
        for (int i = 0; i < 8; ++i) { const float y1 = x1[i] * r * g[i], y2 = x2[i] * r * g[32 + i], c = ct[i], sn = st[i]; o1[i] = y1 * c - y2 * sn; o2[i] = y2 * c + y1 * sn; }
        v2u w1, w2; w1.x = pack4_fp8(16.f * o1[0], 16.f * o1[1], 16.f * o1[2], 16.f * o1[3]); w1.y = pack4_fp8(16.f * o1[4], 16.f * o1[5], 16.f * o1[6], 16.f * o1[7]);
        w2.x = pack4_fp8(16.f * o2[0], 16.f * o2[1], 16.f * o2[2], 16.f * o2[3]); w2.y = pack4_fp8(16.f * o2[4], 16.f * o2[5], 16.f * o2[6], 16.f * o2[7]);
        unsigned char* q1 = qk8 + (size_t)t * 5120 + head * 128 + axis * 64 + f0; *(GAS v2u*)q1 = w1; *(GAS v2u*)(q1 + 32) = w2;
    }
}

__device__ __forceinline__ void attention_phase(const Frame& F, const unsigned char* qk8, const unsigned char* v8, unsigned char* o, char* lds) {
    for (int u = F.vcu; u < 2048; u += F.G) {
        const int bk = u >> 6, rem = u & 63, g = rem >> 4, qb = rem & 15, b = bk >> 3, kvh = bk & 7, h = kvh * 4 + g;
        const size_t row0 = (size_t)b * SEQ;
        const unsigned char* Qb = qk8 + (row0 + qb * 256) * 5120 + h * 128;
        const unsigned char* Kh = qk8 + row0 * 5120 + 4096 + kvh * 128;
        const unsigned char* Vh = v8 + row0 * 1024 + kvh * 128;
        unsigned char* Ob = o + (row0 + qb * 256) * DM + h * 128;
        att::attn_dense_body(Qb, Kh, Vh, Ob, SEQ, lds);
    }
}

__device__ __forceinline__ float pk7(float v, int idx) { return __uint_as_float((__float_as_uint(v) & ~0x7Fu) | (unsigned)idx); }
__device__ __forceinline__ float pk8(float v, unsigned code) { return __uint_as_float((__float_as_uint(v) & ~0xFFu) | code); }
__device__ __forceinline__ void select_half(float (&L)[16], const bf16* qrow  , const bf16* skhp  , int hi) {
    bf16x8 qf[8];
#pragma unroll
    for (int d0 = 0; d0 < 8; ++d0) qf[d0] = *(const GAS bf16x8*)(qrow + d0 * 16);
    float v[4][16];
#pragma unroll
    for (int kt = 0; kt < 4; ++kt) {
        f32x16 acc = {};
        const bf16* kb = skhp + kt * 32 * 128; asm volatile("" : "+v"(kb));
#pragma unroll
        for (int d0 = 0; d0 < 8; ++d0) { const bf16x8 kf = *(const GAS bf16x8*)(kb + d0 * 16); acc = __builtin_amdgcn_mfma_f32_32x32x16_bf16(kf, qf[d0], acc, 0, 0, 0); }
#pragma unroll
        for (int r = 0; r < 16; ++r) v[kt][r] = pk7(acc[r], (kt * 32 + (r & 3) + 8 * (r >> 2)) | (hi << 2));
    }
    seln::top16_of_64(v);
    float a[16], b[16];
#pragma unroll
    for (int i = 0; i < 16; ++i) { const auto rr = __builtin_amdgcn_permlane32_swap(__float_as_uint(v[0][i]), __float_as_uint(v[0][i]), false, false); a[i] = __uint_as_float(rr[0]); b[i] = __uint_as_float(rr[1]); }
    seln::merge16(a, b);
#pragma unroll
    for (int i = 0; i < 16; ++i) L[i] = a[i];
}
__device__ __forceinline__ void select_phase(const Frame& F, const bf16* pq, const bf16* sk, int* idxo, float* gateo) {
    const int lane = F.lane, r32 = lane & 31, hi = lane >> 5;
    LAS unsigned char* myl = F.lds + RING_OFF + (F.wave * 64 + lane) * 32;
    for (int it = F.gw; it < (T / 32) * 8; it += F.NGW) {
        const int tb = it >> 3, h = it & 7, t = tb * 32 + r32;
        float L0[16], L1[16];
        select_half(L0, pq + (size_t)t * PQD + h * 256 + hi * 8, sk + (size_t)((h * 2 + 0) * 128 + r32) * 128 + hi * 8, hi);
        select_half(L1, pq + (size_t)t * PQD + h * 256 + 128 + hi * 8, sk + (size_t)((h * 2 + 1) * 128 + r32) * 128 + hi * 8, hi);
        float c[4][16];
    c[0][0] = pk8(L0[0] + L1[0], 0x00u);
    c[0][1] = pk8(L0[0] + L1[1], 0x01u);
    c[0][2] = pk8(L0[0] + L1[2], 0x02u);
    c[0][3] = pk8(L0[0] + L1[3], 0x03u);
    c[0][4] = pk8(L0[0] + L1[4], 0x04u);
    c[0][5] = pk8(L0[0] + L1[5], 0x05u);
    c[0][6] = pk8(L0[0] + L1[6], 0x06u);
    c[0][7] = pk8(L0[0] + L1[7], 0x07u);
    c[0][8] = pk8(L0[0] + L1[8], 0x08u);
    c[0][9] = pk8(L0[0] + L1[9], 0x09u);
    c[0][10] = pk8(L0[0] + L1[10], 0x0au);
    c[0][11] = pk8(L0[0] + L1[11], 0x0bu);
    c[0][12] = pk8(L0[0] + L1[12], 0x0cu);
    c[0][13] = pk8(L0[0] + L1[13], 0x0du);
    c[0][14] = pk8(L0[0] + L1[14], 0x0eu);
    c[0][15] = pk8(L0[0] + L1[15], 0x0fu);
    c[1][0] = pk8(L0[1] + L1[0], 0x10u);
    c[1][1] = pk8(L0[1] + L1[1], 0x11u);
    c[1][2] = pk8(L0[1] + L1[2], 0x12u);
    c[1][3] = pk8(L0[1] + L1[3], 0x13u);
    c[1][4] = pk8(L0[1] + L1[4], 0x14u);
    c[1][5] = pk8(L0[1] + L1[5], 0x15u);
    c[1][6] = pk8(L0[1] + L1[6], 0x16u);
    c[1][7] = pk8(L0[1] + L1[7], 0x17u);
    c[1][8] = pk8(L0[2] + L1[0], 0x20u);
    c[1][9] = pk8(L0[2] + L1[1], 0x21u);
    c[1][10] = pk8(L0[2] + L1[2], 0x22u);
    c[1][11] = pk8(L0[2] + L1[3], 0x23u);
    c[1][12] = pk8(L0[2] + L1[4], 0x24u);
    c[1][13] = pk8(L0[3] + L1[0], 0x30u);
    c[1][14] = pk8(L0[3] + L1[1], 0x31u);
    c[1][15] = pk8(L0[3] + L1[2], 0x32u);
    c[2][0] = pk8(L0[3] + L1[3], 0x33u);
    c[2][1] = pk8(L0[4] + L1[0], 0x40u);
    c[2][2] = pk8(L0[4] + L1[1], 0x41u);
    c[2][3] = pk8(L0[4] + L1[2], 0x42u);
    c[2][4] = pk8(L0[5] + L1[0], 0x50u);
    c[2][5] = pk8(L0[5] + L1[1], 0x51u);
    c[2][6] = pk8(L0[6] + L1[0], 0x60u);
    c[2][7] = pk8(L0[6] + L1[1], 0x61u);
    c[2][8] = pk8(L0[7] + L1[0], 0x70u);
    c[2][9] = pk8(L0[7] + L1[1], 0x71u);
    c[2][10] = pk8(L0[8] + L1[0], 0x80u);
    c[2][11] = pk8(L0[9] + L1[0], 0x90u);
    c[2][12] = pk8(L0[10] + L1[0], 0xa0u);
    c[2][13] = pk8(L0[11] + L1[0], 0xb0u);
    c[2][14] = pk8(L0[12] + L1[0], 0xc0u);
    c[2][15] = pk8(L0[13] + L1[0], 0xd0u);
    c[3][0] = pk8(L0[14] + L1[0], 0xe0u);
    c[3][1] = pk8(L0[15] + L1[0], 0xf0u);
    c[3][2] = -3.0e38f;
    c[3][3] = -3.0e38f;
    c[3][4] = -3.0e38f;
    c[3][5] = -3.0e38f;
    c[3][6] = -3.0e38f;
    c[3][7] = -3.0e38f;
    c[3][8] = -3.0e38f;
    c[3][9] = -3.0e38f;
    c[3][10] = -3.0e38f;
    c[3][11] = -3.0e38f;
    c[3][12] = -3.0e38f;
    c[3][13] = -3.0e38f;
    c[3][14] = -3.0e38f;
    c[3][15] = -3.0e38f;
        seln::top16_of_64(c);
        v4u w0, w1, w2, w3;
#define B4(L, i) ((__float_as_uint(L[i]) & 0x7Fu) | ((__float_as_uint(L[i + 1]) & 0x7Fu) << 8) | ((__float_as_uint(L[i + 2]) & 0x7Fu) << 16) | ((__float_as_uint(L[i + 3]) & 0x7Fu) << 24))
        w0.x = B4(L0, 0); w0.y = B4(L0, 4); w0.z = B4(L0, 8); w0.w = B4(L0, 12); w1.x = B4(L1, 0); w1.y = B4(L1, 4); w1.z = B4(L1, 8); w1.w = B4(L1, 12);
#undef B4
        *(LAS v4u*)myl = w0; *(LAS v4u*)(myl + 16) = w1;
        LDS_WAIT();
        int e[16]; float gt[16]; float sum = 0.f; const float mx = c[0][0];
#pragma unroll
        for (int k = 0; k < 16; ++k) { const unsigned code = __float_as_uint(c[0][k]) & 0xFFu; const int n1 = myl[code >> 4], n2 = myl[16 + (code & 15u)];
            e[k] = n1 * 128 + n2; gt[k] = __expf(__uint_as_float(__float_as_uint(c[0][k]) & ~0xFFu) - mx); sum += gt[k]; }
        const float rs = 1.0f / sum;
        v4i eo0, eo1; f32x4 go0, go1;
        eo0.x = hi ? e[8] : e[0]; eo0.y = hi ? e[9] : e[1]; eo0.z = hi ? e[10] : e[2]; eo0.w = hi ? e[11] : e[3];
        eo1.x = hi ? e[12] : e[4]; eo1.y = hi ? e[13] : e[5]; eo1.z = hi ? e[14] : e[6]; eo1.w = hi ? e[15] : e[7];
        go0.x = (hi ? gt[8] : gt[0]) * rs; go0.y = (hi ? gt[9] : gt[1]) * rs; go0.z = (hi ? gt[10] : gt[2]) * rs; go0.w = (hi ? gt[11] : gt[3]) * rs;
        go1.x = (hi ? gt[12] : gt[4]) * rs; go1.y = (hi ? gt[13] : gt[5]) * rs; go1.z = (hi ? gt[14] : gt[6]) * rs; go1.w = (hi ? gt[15] : gt[7]) * rs;
        const size_t ob = (size_t)t * SLOTS + h * 16 + hi * 8;
        *(GAS v4i*)(idxo + ob) = eo0; *(GAS v4i*)(idxo + ob + 4) = eo1; *(GAS f32x4*)(gateo + ob) = go0; *(GAS f32x4*)(gateo + ob + 4) = go1;
        LDS_WAIT();
    }
}

struct XInfo { int pj, nx, rank, nloc; };
constexpr int NSUB = 2, PCOLS = 512 / NSUB, NPART = 8 * NSUB, NPART_U = 8;
#define dpp_f(v, CTRL) __uint_as_float((unsigned)__builtin_amdgcn_update_dpp(0, (int)__float_as_uint(v), CTRL, 0xF, 0xF, true))
__device__ __forceinline__ void experts_u_phase(const Frame& F, const XInfo X, const unsigned char* xh, const unsigned char* xl, const int* idx, const unsigned char* U, float* part) {
    const int lane = F.lane, n = lane & 15, kq = lane >> 4, ci = lane & 3, sj = (lane >> 2) & 3;
    LAS int* le = (LAS int*)(F.lds + RING_OFF + F.wave * 1024);
    const int lw = 32 * (lane & 3) + (lane >> 2);
    const int tstride = X.nloc * NWAVES, tfirst = X.rank * NWAVES + F.wave;
    if (tfirst >= T) return;
    const int tlast = tfirst + ((T - 1 - tfirst) / tstride) * tstride;
#define UBASE(e) (((unsigned)(e) << 8) + (unsigned)coff)
#define ULOADB(b) (*(const GAS v4u*)(tab + (b)))
    for (int s = X.pj; s < 8; s += X.nx) {
        const unsigned char* tab = U; const int cbase = s * 512, coff = s * (NEXP * 256) + (ci + 4 * kq) * 16;
        const unsigned char* xcol = xh + cbase + ((n & 3) + 4 * (kq >> 1)) * 32 + 16 * (kq & 1); (void)xl;
        int par = 0, t = tfirst, tn = t < tlast ? t + tstride : t;
        le[lw] = idx[(size_t)t * SLOTS + lane]; le[lw + 16] = idx[(size_t)t * SLOTS + 64 + lane];
        v4u xc0 = {0u, 0u, 0u, 0u}, xc1 = {0u, 0u, 0u, 0u}; if (n < 4) { const GAS v4u* xp = (const GAS v4u*)(xcol + (size_t)t * DM); xc0 = xp[0]; xc1 = xp[16]; }
        int in0 = idx[(size_t)tn * SLOTS + lane], in1 = idx[(size_t)tn * SLOTS + 64 + lane];
        LDS_WAIT();
        v4u R[32];
#pragma unroll
        for (int g = 0; g < 32; ++g) R[g] = ULOADB(UBASE(le[32 * sj + g]));
        for (;;) {
            const int t2 = tn < tlast ? tn + tstride : tn;
            le[128 * (par ^ 1) + lw] = in0; le[128 * (par ^ 1) + lw + 16] = in1;
            const int j0 = idx[(size_t)t2 * SLOTS + lane], j1 = idx[(size_t)t2 * SLOTS + 64 + lane];
            att::v8i_t xb;
            { const unsigned wv[8] = {xc0.x, xc0.y, xc0.z, xc0.w, xc1.x, xc1.y, xc1.z, xc1.w};
#pragma unroll
              for (int q = 0; q < 8; ++q) xb[q] = (n < 4) ? (int)wv[q] : 0; }
            if (n < 4) { const GAS v4u* xp = (const GAS v4u*)(xcol + (size_t)tn * DM); xc0 = xp[0]; xc1 = xp[16]; }
            float res[8] = {0.f, 0.f, 0.f, 0.f, 0.f, 0.f, 0.f, 0.f};
#define UM(G, D) do { v4i a = __builtin_bit_cast(v4i, R[(G)]); asm volatile("" : "+v"(a)); \
                D = __builtin_amdgcn_mfma_scale_f32_16x16x128_f8f6f4(__builtin_shufflevector(a, a, 0, 1, 2, 3, -1, -1, -1, -1), xb, (f32x4){0.f, 0.f, 0.f, 0.f}, 4, 0, 0, 0, 0, 0); } while (0)
#define UV(G, D) do { asm volatile("" : "+v"(D)); float s1_, s2_, v; \
                if (((G) & 1) == 0) { s1_ = D.x + dpp_f(D.y, 0xF5); s2_ = D.z + dpp_f(D.w, 0xF5); }     \
                else                { s1_ = D.y + dpp_f(D.x, 0xA0); s2_ = D.w + dpp_f(D.z, 0xA0); }     \
                if (((G) & 3) == 0) v = s1_ + dpp_f(s2_, 0xAA); else if (((G) & 3) == 2) v = s2_ + dpp_f(s1_, 0x00); else if (((G) & 3) == 1) v = s1_ + dpp_f(s2_, 0xFF); else v = s2_ + dpp_f(s1_, 0x55); \
                res[(G) >> 2] = (n == ((G) & 3)) ? v : res[(G) >> 2]; asm volatile("" : "+v"(res[(G) >> 2])); } while (0)
            LDS_WAIT();
            f32x4 Da, Db;
            __builtin_amdgcn_sched_barrier(0);
#pragma unroll
            for (int g4 = 0; g4 < 8; ++g4) {
                const v4i idv = *(const LAS v4i*)(le + 128 * (par ^ 1) + 32 * sj + 4 * g4);
                UM(4 * g4, Da); R[4 * g4] = ULOADB(UBASE(idv.x)); __builtin_amdgcn_sched_barrier(0); if (g4 > 0) UV(4 * g4 - 1, Db); __builtin_amdgcn_sched_barrier(0);
                UM(4 * g4 + 1, Db); R[4 * g4 + 1] = ULOADB(UBASE(idv.y)); __builtin_amdgcn_sched_barrier(0); UV(4 * g4, Da); __builtin_amdgcn_sched_barrier(0);
                UM(4 * g4 + 2, Da); R[4 * g4 + 2] = ULOADB(UBASE(idv.z)); __builtin_amdgcn_sched_barrier(0); UV(4 * g4 + 1, Db); __builtin_amdgcn_sched_barrier(0);
                UM(4 * g4 + 3, Db); R[4 * g4 + 3] = ULOADB(UBASE(idv.w)); __builtin_amdgcn_sched_barrier(0); UV(4 * g4 + 2, Da); __builtin_amdgcn_sched_barrier(0); }
            UV(31, Db);
#undef UM
#undef UV
            if (n < 4) { typedef _Float16 h2 __attribute__((ext_vector_type(2)));
                v4u pk;
                { const h2 a = {(_Float16)(res[0] * 0.0625f), (_Float16)(res[1] * 0.0625f)}, b = {(_Float16)(res[2] * 0.0625f), (_Float16)(res[3] * 0.0625f)}, c = {(_Float16)(res[4] * 0.0625f), (_Float16)(res[5] * 0.0625f)}, d = {(_Float16)(res[6] * 0.0625f), (_Float16)(res[7] * 0.0625f)};
                  pk.x = __builtin_bit_cast(unsigned, a); pk.y = __builtin_bit_cast(unsigned, b); pk.z = __builtin_bit_cast(unsigned, c); pk.w = __builtin_bit_cast(unsigned, d); }
                *(GAS v4u*)((_Float16*)part + ((size_t)t * NPART_U + s) * SLOTS + (4 * n + kq) * 8) = pk; }
            if (t == tlast) break;
            t = tn; tn = t2; par ^= 1; in0 = j0; in1 = j1;
        }
        LDS_WAIT();
    }
#undef UBASE
#undef ULOADB
}
__device__ __forceinline__ void glds16_off(unsigned voff, const void* gbase, unsigned lds_dst) { unsigned keep;
    asm volatile("s_mov_b32 %0, m0\n\ts_mov_b32 m0, %2\n\ts_nop 0\n\tglobal_load_lds_dwordx4 %1, %3\n\ts_mov_b32 m0, %0" : "=&s"(keep) : "v"(voff), "s"(lds_dst), "s"(gbase) : "memory"); }
__device__ __forceinline__ void experts_w_phase(const Frame& F, const int* idx, const float* gate, const float* part, const float* isU, const float* isV, unsigned char* wh8, unsigned char* wl8, float* wsi) {
    for (int t = F.gw; t < T; t += F.NGW) {
        float w[2];
#pragma unroll
        for (int q = 0; q < 2; ++q) { const int k = F.lane + 64 * q; const int e = idx[(size_t)t * SLOTS + k];
            float sum = 0.f;
#pragma unroll
            for (int j = 0; j < NPART_U; ++j) sum += (float)((const _Float16*)part)[((size_t)t * NPART_U + j) * SLOTS + ((k & 15) << 3) + (k >> 4)];
            sum *= isU[e];
            w[q] = gate[(size_t)t * SLOTS + k] * isV[e] * (0.5f * sum * (1.0f + erff(sum * 0.70710678118654752f))); }
        float mx = fmaxf(fabsf(w[0]), fabsf(w[1]));
#pragma unroll
        for (int o = 1; o < 64; o <<= 1) mx = fmaxf(mx, __shfl_xor(mx, o));
        const float sw = mx > 0.f ? 224.f / mx : 1.f;
#pragma unroll
        for (int q = 0; q < 2; ++q) { const float y = w[q] * sw;
            const int hb = __builtin_amdgcn_cvt_pk_fp8_f32(y, 0.f, 0, false) & 0xFF;
            { const int k = F.lane + 64 * q; wh8[(size_t)t * SLOTS + 32 * ((k >> 3) & 3) + 8 * (k >> 5) + (k & 7)] = (unsigned char)hb; } (void)wl8; }
        if (F.lane == 0) wsi[t] = mx > 0.f ? mx * (1.f / 224.f) : 1.f;
    }
}
template <bool FINAL>
__device__ __forceinline__ void experts_v_phase(const Frame& F, const XInfo X, const int* idx, const unsigned char* wh8, const unsigned char* wl8, const float* wsi, const unsigned char* V, bf16* h, float* hout) {
    const int lane = F.lane, n = lane & 15, kq = lane >> 4;
    constexpr int VSLOT = 1040;
    LAS unsigned char* ringp = F.lds + RING_OFF + F.wave * (16 * VSLOT);
    LAS int* le2 = (LAS int*)(F.lds + VL_OFF + F.wave * VL_WAVE);
    LAS float* stage = (LAS float*)ringp;
    const unsigned ring_addr = (unsigned)(__SIZE_TYPE__)ringp;
    const int trb = (int)ring_addr + (2 * (kq & 1) + ((n >> 1) & 1)) * VSLOT + 64 * (n >> 2) + 16 * (kq >> 1) + 8 * (n & 1);
    const int lp = 32 * ((lane >> 1) & 3) + 8 * (lane >> 5) + 4 * ((lane >> 3) & 1) + 2 * ((lane >> 4) & 1) + (lane & 1);
    const unsigned selE = (n & 1) ? 0x010c000cu : 0x0c010c00u, selO = (n & 1) ? 0x030c020cu : 0x0c030c02u;
    const unsigned mlo = (n < 2) ? 0xFFFFFFFFu : 0u, mhi = (n >= 2 && n < 4) ? 0xFFFFFFFFu : 0u;
    for (int s = X.pj; s < 8; s += X.nx) {
        const int cbase = s * 512; const unsigned coff = (unsigned)(s * (NEXP * 256) + 64 * kq + 16 * (lane & 3));
        const int tfirst = X.rank * NWAVES + F.wave, tstep = X.nloc * NWAVES;
        if (tfirst >= T) continue;
        int pid0 = idx[(size_t)tfirst * SLOTS + lane], pid1 = idx[(size_t)tfirst * SLOTS + 64 + lane];
        v2u pBw[4]; float prsw = wsi[tfirst];
        { const GAS v4u* wsrc = (const GAS v4u*)(wh8 + (size_t)tfirst * SLOTS + 32 * kq); (void)wl8; const v4u wa = wsrc[0], wb = wsrc[1];
          pBw[0] = (v2u){wa.x, wa.y}; pBw[1] = (v2u){wa.z, wa.w}; pBw[2] = (v2u){wb.x, wb.y}; pBw[3] = (v2u){wb.z, wb.w}; }
        for (int t = tfirst; t < T; t += tstep) {
            le2[lp] = pid0; le2[lp + 16] = pid1;
            v2u Bw[4];
#pragma unroll
            for (int sb = 0; sb < 4; ++sb) Bw[sb] = pBw[sb];
            const float rsw = prsw;
            { const int tn = t + tstep < T ? t + tstep : t;
              pid0 = idx[(size_t)tn * SLOTS + lane]; pid1 = idx[(size_t)tn * SLOTS + 64 + lane]; prsw = wsi[tn];
              const GAS v4u* wsrc = (const GAS v4u*)(wh8 + (size_t)tn * SLOTS + 32 * kq); const v4u wa = wsrc[0], wb = wsrc[1];
              pBw[0] = (v2u){wa.x, wa.y}; pBw[1] = (v2u){wa.z, wa.w}; pBw[2] = (v2u){wb.x, wb.y}; pBw[3] = (v2u){wb.z, wb.w}; }
            LDS_WAIT();
            unsigned base[32];
#pragma unroll
            for (int L = 0; L < 32; ++L) base[L] = ((unsigned)le2[32 * ((lane >> 2) & 3) + L] << 8) + coff;
            f32x4 D[8]; v4u hold;
#pragma unroll
            for (int j = 0; j < 8; ++j) D[j] = (f32x4){0.f, 0.f, 0.f, 0.f};
#define VDMA(L) glds16_off(base[L], V, ring_addr + ((L) & 15) * VSLOT)
            asm volatile("" ::: "memory");
#pragma unroll
            for (int L = 0; L < 16; ++L) VDMA(L);
#pragma unroll
            for (int sb = 0; sb < 4; ++sb) {
                if (sb < 2) asm volatile("s_waitcnt vmcnt(8)" ::: "memory"); else if (sb == 2) asm volatile("s_waitcnt vmcnt(9)" ::: "memory");   else asm volatile("s_waitcnt vmcnt(0)" ::: "memory");
                v2i a0[8], a1[8];
#pragma unroll
                for (int j = 0; j < 8; ++j) {
                    asm volatile("ds_read_b64_tr_b8 %0, %1 offset:%2" : "=&v"(a0[j]) : "v"(trb), "i"(((sb & 1) * 8) * VSLOT + 256 * (j >> 1) + 32 * (j & 1)) : "memory");
                    asm volatile("ds_read_b64_tr_b8 %0, %1 offset:%2" : "=&v"(a1[j]) : "v"(trb), "i"(((sb & 1) * 8 + 4) * VSLOT + 256 * (j >> 1) + 32 * (j & 1)) : "memory"); }
                asm volatile("s_waitcnt lgkmcnt(0)" ::: "memory"); __builtin_amdgcn_sched_barrier(0);
                if (sb < 2) {
#pragma unroll
                    for (int L8 = 0; L8 < 8; ++L8) VDMA(16 + 8 * sb + L8);
                }
                if (sb == 1) { hold = *(const GAS v4u*)(h + (size_t)t * DM + cbase + 8 * lane); asm volatile("" ::: "memory"); }
                att::v8i_t B;
                { const unsigned e0 = __builtin_amdgcn_perm(0u, Bw[sb].x, selE), e1 = __builtin_amdgcn_perm(0u, Bw[sb].x, selO), e2 = __builtin_amdgcn_perm(0u, Bw[sb].y, selE), e3 = __builtin_amdgcn_perm(0u, Bw[sb].y, selO);
                  B[0] = (int)(e0 & mlo); B[1] = (int)(e1 & mlo); B[2] = (int)(e2 & mlo); B[3] = (int)(e3 & mlo); B[4] = (int)(e0 & mhi); B[5] = (int)(e1 & mhi); B[6] = (int)(e2 & mhi); B[7] = (int)(e3 & mhi); }
#pragma unroll
                for (int j = 0; j < 8; ++j) { const att::v8i_t A = {a0[j].x, a0[j].y, a1[j].x, a1[j].y, 0, 0, 0, 0};
                    D[j] = __builtin_amdgcn_mfma_scale_f32_16x16x128_f8f6f4(A, B, D[j], 4, 0, 0, 0, 0, 0); }
                __builtin_amdgcn_sched_barrier(0);
            }
#undef VDMA
            if (n < 4) {
#pragma unroll
                for (int j = 0; j < 8; ++j) *(LAS f32x4*)(stage + 32 * (2 * j + (n >> 1)) + 16 * (n & 1) + 4 * kq) = D[j];
            }
            LDS_WAIT();
            { const f32x4 ha = *(const LAS f32x4*)(stage + 8 * lane), hb = *(const LAS f32x4*)(stage + 8 * lane + 4);
              f32x4 oa = (f32x4){bflo(hold.x), bfhi(hold.x), bflo(hold.y), bfhi(hold.y)}, ob = (f32x4){bflo(hold.z), bfhi(hold.z), bflo(hold.w), bfhi(hold.w)};
              oa.x += ha.x * rsw; oa.y += ha.y * rsw; oa.z += ha.z * rsw; oa.w += ha.w * rsw; ob.x += hb.x * rsw; ob.y += hb.y * rsw; ob.z += hb.z * rsw; ob.w += hb.w * rsw;
              if constexpr (FINAL) { GAS f32x4* op = (GAS f32x4*)(hout + (size_t)t * DM + cbase + 8 * lane); op[0] = oa; op[1] = ob; }
              else { v4u w; w.x = pk2(oa.x, oa.y); w.y = pk2(oa.z, oa.w); w.z = pk2(ob.x, ob.y); w.w = pk2(ob.z, ob.w); *(GAS v4u*)(h + (size_t)t * DM + cbase + 8 * lane) = w; } }
            LDS_WAIT();
        }
    }
}

__device__ __forceinline__ void load_u8(float (&u)[8], const bf16* p) {
    const v4u c = *(const GAS v4u*)p;
    u[0] = bflo(c.x); u[1] = bfhi(c.x); u[2] = bflo(c.y); u[3] = bfhi(c.y); u[4] = bflo(c.z); u[5] = bfhi(c.z); u[6] = bflo(c.w); u[7] = bfhi(c.w);
}
__device__ __forceinline__ void conv_phase(const Frame& F, const bf16* bg, const bf16* ub, const float* cw, const float* cb, bf16* y) {
    for (int it = F.gw; it < (T / 32) * 8; it += F.NGW) {
        const int run = it >> 3, ch = (it & 7) * 512 + F.lane * 8, t0 = run * 32;
        float w0[8], w1[8], w2[8], bb[8];
#pragma unroll
        for (int i = 0; i < 8; ++i) { w0[i] = cw[ch + i]; w1[i] = cw[DM + ch + i]; w2[i] = cw[2 * DM + ch + i]; bb[i] = cb[ch + i]; }
        float up[8], uc[8], un[8];
        if ((t0 & (SEQ - 1)) == 0) {
#pragma unroll
            for (int i = 0; i < 8; ++i) up[i] = 0.f;
        } else load_u8(up, ub + (size_t)(t0 - 1) * DM + ch);
        load_u8(uc, ub + (size_t)t0 * DM + ch);
        for (int i0 = 0; i0 < 32; i0 += 8) {
            v4u ur[8], br[8];
#pragma unroll
            for (int q = 0; q < 8; ++q) { const int t = t0 + i0 + q; const bool last = (t & (SEQ - 1)) == SEQ - 1;
                ur[q] = *(const GAS v4u*)(ub + (size_t)(last ? t : t + 1) * DM + ch); if (last) ur[q] = (v4u){0u, 0u, 0u, 0u};
                br[q] = *(const GAS v4u*)(bg + (size_t)t * DM + ch); }
#pragma unroll
            for (int q = 0; q < 8; ++q) { const int t = t0 + i0 + q;
                un[0] = bflo(ur[q].x); un[1] = bfhi(ur[q].x); un[2] = bflo(ur[q].y); un[3] = bfhi(ur[q].y); un[4] = bflo(ur[q].z); un[5] = bfhi(ur[q].z); un[6] = bflo(ur[q].w); un[7] = bfhi(ur[q].w);
                const float bgv[8] = {bflo(br[q].x), bfhi(br[q].x), bflo(br[q].y), bfhi(br[q].y), bflo(br[q].z), bfhi(br[q].z), bflo(br[q].w), bfhi(br[q].w)};
                float o[8];
#pragma unroll
                for (int c = 0; c < 8; ++c) { const float cv = up[c] * w0[c] + uc[c] * w1[c] + un[c] * w2[c] + bb[c]; o[c] = bgv[c] * cv; up[c] = uc[c]; uc[c] = un[c]; }
                v4u w; w.x = pk2(o[0], o[1]); w.y = pk2(o[2], o[3]); w.z = pk2(o[4], o[5]); w.w = pk2(o[6], o[7]);
                *(GAS v4u*)(y + (size_t)t * DM + ch) = w; }
        }
    }
}

constexpr int NPHASE = 17;
struct Args { const float* in[15]; float* out; unsigned char* ws; int ph_lo, ph_hi; };
static_assert(sizeof(Args) == 15 * 8 + 8 + 8 + 8, "Args has no padding");
__global__ void __launch_bounds__(NWAVES * 64, 2) mk_fwd(Args args) {
    extern __shared__ __attribute__((aligned(16))) unsigned char lds_raw[];
    Frame F;
    F.lds = (LAS unsigned char*)lds_raw;
    F.tid = threadIdx.x; F.lane = F.tid & 63; F.wave = __builtin_amdgcn_readfirstlane(F.tid >> 6);
    F.G = gridDim.x; { const int bx = blockIdx.x; F.vcu = (F.G % 8 == 0) ? (bx % 8) * (F.G / 8) + bx / 8 : bx; }
    F.gw = F.vcu * NWAVES + F.wave; F.NGW = F.G * NWAVES;
    unsigned char* ws = args.ws;
    gu32* ctl = (gu32*)(ws + WS_CTL);
    volatile LAS unsigned* MISC = (volatile LAS unsigned*)(F.lds + MISC_OFF);
    for (int u = F.tid; u < (LDS_BYTES - MISC_OFF) / 4; u += NWAVES * 64) ((LAS unsigned*)(F.lds + MISC_OFF))[u] = 0u;
    __syncthreads();
    XcdBarrier bar; bar.bar = (unsigned*)(ctl + CW_BAR); bar.x = 0; bar.st = nullptr;
    const int lo = args.ph_lo, hi = args.ph_hi;
    if (hi - lo > 1) bar = xcd_barrier_post((unsigned*)(ctl + CW_BAR), MISC + 8);
    const int xid = (int)xb_xcc_id();
    if (F.tid == 0) MISC[16] = __hip_atomic_fetch_add(ctl + CW_RANK + 64 * xid, 1u, RLX_AGENT);
    __syncthreads();
    XInfo X; X.rank = __builtin_amdgcn_readfirstlane((int)MISC[16]); X.pj = 0; X.nx = 1; X.nloc = 1;
#ifndef MK_ONLY
#define MK_ONLY -1
#endif
#define IN(k) ((MK_ONLY < 0 || MK_ONLY == (k)) && lo <= (k) && (k) < hi)
#define SEAM(k) do { if (IN(k) && IN((k) + 1)) xcd_barrier(bar); } while (0)
    const float* x = args.in[0]; const float* mixer_g = args.in[1]; const float* ffn_g = args.in[2];
    float* out = args.out;
    unsigned char* WQKV8 = ws + WS_WQKV; unsigned char* HN8 = ws + WS_HN; float* SCL = (float*)(ws + WS_ISC + 262144); unsigned char* WO8 = ws + WS_WO; unsigned char* O8 = ws + WS_O; unsigned char* QK8 = ws + WS_BCX; unsigned char* V8A = ws + WS_BCX + 80 * MiB;   bf16* Win_t = (bf16*)(ws + WS_WIN); bf16* Wout_t = (bf16*)(ws + WS_WOUT);
    bf16* Wpq_t = (bf16*)(ws + WS_WPQ); bf16* SK = (bf16*)(ws + WS_SK); float* ROPE = (float*)(ws + WS_ROPE); unsigned char* U8 = ws + WS_U;   unsigned char* X8H = ws + WS_O; unsigned char* X8L = ws + WS_O + 64 * MiB;   unsigned char* V8 = ws + WS_V; float* ISU = (float*)(ws + WS_ISC); float* ISV = ISU + 2 * NEXP;
    bf16* HN = (bf16*)(ws + WS_HN); bf16* QKV = (bf16*)(ws + WS_QKV); bf16* HB = (bf16*)(ws + WS_QKV); float* RS = (float*)(ws + WS_ROPE + 524288);     bf16* OB = (bf16*)(ws + WS_O); bf16* PQ = (bf16*)(ws + WS_PQ);
    float* PART = (float*)(ws + WS_PART); unsigned char* WH8 = ws + WS_WQ8; unsigned char* WL8 = WH8 + (size_t)T * SLOTS; float* WSI = (float*)(WL8 + (size_t)T * SLOTS); int* IDX = (int*)(ws + WS_IDX); float* GATE = (float*)(ws + WS_GATE); bf16* BCX = (bf16*)(ws + WS_BCX); bf16* YB = (bf16*)(ws + WS_Y);
    PG8_LAS unsigned char* ring = (PG8_LAS unsigned char*)(F.lds + RING_OFF);

    if (IN(0)) {
        amax_tensor(F, args.in[3], (size_t)DM * QKVD / 4, ctl + CW_AMAX);
        amax_tensor(F, args.in[4], (size_t)DM * DM / 4, ctl + CW_AMAX + 64);
        xcd_barrier(bar);
        const f32x2 sq = pow2_scale(__hip_atomic_load(ctl + CW_AMAX, RLX_AGENT)), so = pow2_scale(__hip_atomic_load(ctl + CW_AMAX + 64, RLX_AGENT));
        if (blockIdx.x == 0 && F.tid == 0) { SCL[0] = sq.y; SCL[1] = so.y; }
        transpose_all<false, true>(F, args.in[3], DM, QKVD, WQKV8, sq.x);
        transpose_all<false, true>(F, args.in[4], DM, DM, WO8, so.x);
        transpose_all<true, false>(F, args.in[7], DM, CIN, Win_t, 1.f, mixer_g + DM);
        transpose_all(F, args.in[10], DM, DM, Wout_t);
        transpose_all(F, args.in[11], DM, PQD, Wpq_t, 1.f, ffn_g);
        transpose_all(F, args.in[11] + (size_t)DM * PQD, DM, PQD, Wpq_t + (size_t)PQD * DM, 1.f, ffn_g + DM);
        cvt_copy(F, args.in[12], SK, (size_t)2 * 16 * 128 * 128 / 8);
        cvt_rows_fp4<false>(F, args.in[13], U8, ISU, 2 * NEXP);
        cvt_rows_fp4<true>(F, args.in[14], V8, ISV, 2 * NEXP);
        if (F.vcu == 0) rope_table(F, ROPE);
        for (int m = F.gw; m < T; m += F.NGW) rms_row_to_fp8(x + (size_t)m * DM, mixer_g, HN8 + (size_t)m * DM, F.lane);
    }
    SEAM(0);
    { int nx = 0, pj = 0, nloc = 1;
#pragma unroll
      for (int j = 0; j < 16; ++j) { const int cj = (int)__hip_atomic_load(ctl + CW_RANK + 64 * j, RLX_AGENT); nx += cj > 0; pj += (cj > 0 && j < xid); nloc = (j == xid) ? cj : nloc; }
      X.nx = __builtin_amdgcn_readfirstlane(nx > 0 ? nx : 1); X.pj = __builtin_amdgcn_readfirstlane(pj); X.nloc = __builtin_amdgcn_readfirstlane(nloc > 0 ? nloc : 1); }
    if (IN(1)) { pg8::Gemm g{(const bf16*)HN8, (const bf16*)WQKV8, T, QKVD, DM / 2}; pg8::StaticOrder S; S.init(T, QKVD, F.G, (int)blockIdx.x);
        pg8::EpiBf16S E{QKV, QKVD, SCL, 0.0625f, (unsigned*)(ctl + CW_AMAX + 128), 5120};
        pg8::gemm_phase<pg8::EpiBf16S, pg8::StaticOrder, true, true, true>(ring, g, S, E); }
    SEAM(1);
    if (IN(2)) qknorm_rope_phase(F, QKV, QK8, V8A, args.in[5], args.in[6], ROPE, ctl + CW_AMAX + 128);
    SEAM(2);
    if (IN(3)) { const f32x2 sv = pow2_scale(__hip_atomic_load(ctl + CW_AMAX + 128, RLX_AGENT)); if (blockIdx.x == 0 && F.tid == 0) SCL[2] = sv.y;
        attention_phase(F, QK8, V8A, O8, (char*)lds_raw + RING_OFF); }
    SEAM(3);
    if (IN(4)) { pg8::Gemm g{(const bf16*)O8, (const bf16*)WO8, T, DM, DM / 2}; pg8::StaticOrder S; S.init(T, DM, F.G, (int)blockIdx.x);
        pg8::EpiBf16ResS E{HB, x, DM, SCL + 1, SCL + 2};
        pg8::gemm_phase<pg8::EpiBf16ResS, pg8::StaticOrder, true, true, true>(ring, g, S, E); }
    SEAM(4);
    if (IN(5)) norm_phase_b<true>(F, HB, ffn_g, RS, X8H);
    SEAM(5);
    if (IN(6)) { pg8::Gemm g{HB, Wpq_t, T, PQD, DM}; pg8::StaticOrder S; S.init(T, PQD, F.G, (int)blockIdx.x);
        pg8::EpiBf16Row E{PQ, PQD, RS};
        pg8::gemm_phase<pg8::EpiBf16Row, pg8::StaticOrder, true, true>(ring, g, S, E); }
    SEAM(6);
    if (IN(7)) select_phase(F, PQ, SK, IDX, GATE);
    SEAM(7);
    if (IN(8)) { experts_u_phase(F, X, X8H, X8L, IDX, U8, PART); xcd_barrier(bar); experts_w_phase(F, IDX, GATE, PART, ISU, ISV, WH8, WL8, WSI); xcd_barrier(bar); experts_v_phase<false>(F, X, IDX, WH8, WL8, WSI, V8, HB, out); }
    SEAM(8);
    if (IN(9)) norm_phase_b<false>(F, HB, mixer_g + DM, RS, nullptr);
    SEAM(9);
    if (IN(10)) { pg8::Gemm g{HB, Win_t, T, CIN, DM}; pg8::StaticOrder S; S.init(T, CIN, F.G, (int)blockIdx.x);
        pg8::EpiConvIn E{BCX, BCX + (size_t)T * DM, DM, RS};
        pg8::gemm_phase<pg8::EpiConvIn, pg8::StaticOrder, true, true>(ring, g, S, E); }
    SEAM(10);
    if (IN(11)) conv_phase(F, BCX, BCX + (size_t)T * DM, args.in[8], args.in[9], YB);
    SEAM(11);
    if (IN(12)) { pg8::Gemm g{YB, Wout_t, T, DM, DM}; pg8::StaticOrder S; S.init(T, DM, F.G, (int)blockIdx.x);
        pg8::EpiBf16Res E{HB, DM};
        pg8::gemm_phase<pg8::EpiBf16Res, pg8::StaticOrder, true, true>(ring, g, S, E); }
    SEAM(12);
    if (IN(13)) norm_phase_b<true>(F, HB, ffn_g + DM, RS, X8H);
    SEAM(13);
    if (IN(14)) { pg8::Gemm g{HB, Wpq_t + (size_t)PQD * DM, T, PQD, DM}; pg8::StaticOrder S; S.init(T, PQD, F.G, (int)blockIdx.x);
        pg8::EpiBf16Row E{PQ, PQD, RS};
        pg8::gemm_phase<pg8::EpiBf16Row, pg8::StaticOrder, true, true>(ring, g, S, E); }
    SEAM(14);
    if (IN(15)) select_phase(F, PQ, SK + (size_t)16 * 128 * 128, IDX, GATE);
    SEAM(15);
    if (IN(16)) { experts_u_phase(F, X, X8H, X8L, IDX, U8 + (size_t)NEXP * (DM / 2), PART); xcd_barrier(bar); experts_w_phase(F, IDX, GATE, PART, ISU + NEXP, ISV + NEXP, WH8, WL8, WSI); xcd_barrier(bar); experts_v_phase<true>(F, X, IDX, WH8, WL8, WSI, V8 + (size_t)NEXP * (DM / 2), HB, out); }
#undef IN
#undef SEAM
}

extern "C" void kernel_launch(void* const* d_in, const int* in_sizes, int n_in, void* d_out, int out_size, void* d_ws, size_t ws_size, hipStream_t stream) {
    static int grid = 0;
    if (grid == 0) {
        if (n_in != 15 || in_sizes[0] != T * DM || out_size != T * DM || ws_size < WS_END) { fprintf(stderr, "kernel_launch: shape mismatch (n_in %d, in0 %d, out %d, ws %zu < %zu); nothing launched\n", n_in, n_in > 0 ? in_sizes[0] : -1, out_size, ws_size, (size_t)WS_END); grid = -1; return; }
        int dev = 0, cus = 0, per_cu = 0;
        if (hipGetDevice(&dev) != hipSuccess || hipDeviceGetAttribute(&cus, hipDeviceAttributeMultiprocessorCount, dev) != hipSuccess) { grid = -1; return; }
        if (hipFuncSetAttribute((const void*)mk_fwd, hipFuncAttributeMaxDynamicSharedMemorySize, LDS_BYTES) != hipSuccess) { fprintf(stderr, "kernel_launch: hipFuncSetAttribute failed\n"); grid = -1; return; }
        if (hipOccupancyMaxActiveBlocksPerMultiprocessor(&per_cu, (const void*)mk_fwd, NWAVES * 64, LDS_BYTES) != hipSuccess || per_cu < 1) { fprintf(stderr, "kernel_launch: occupancy query reports %d workgroups per CU\n", per_cu); }
        (void)hipGetLastError();
        grid = cus;
    }
    if (grid < 0) return;
    if (hipMemsetAsync((char*)d_ws + WS_CTL, 0, CTL_ZERO_BYTES, stream) != hipSuccess) return;
    Args a{};
    for (int i = 0; i < 15; ++i) a.in[i] = (const float*)d_in[i];
    a.out = (float*)d_out; a.ws = (unsigned char*)d_ws;
#if MK_PER_PHASE
    for (int p = 0; p < NPHASE; ++p) { a.ph_lo = p; a.ph_hi = p + 1; hipLaunchKernelGGL(mk_fwd, dim3(grid), dim3(NWAVES * 64), LDS_BYTES, stream, a); }
#else
    a.ph_lo = 0; a.ph_hi = NPHASE; hipLaunchKernelGGL(mk_fwd, dim3(grid), dim3(NWAVES * 64), LDS_BYTES, stream, a);
#endif
    const hipError_t le = hipPeekAtLastError();
    if (le != hipSuccess) fprintf(stderr, "kernel_launch: launch failed: %s\n", hipGetErrorName(le));
}
```
